# Optimizing an MI355X kernel written in HIP

```python
import math
import jax, jax.numpy as jnp
from jax import lax
import numpy as np

D_MODEL = 2048
BATCH = 4
SEQ = 4096
DEPTH = 2

N_MEM = 256
BRANCH_WIDTH = 1024
N_BRANCH = 4
DA_HEADS = 8
DA_QK_DIM = 64
DA_V_DIM = 2 * DA_QK_DIM
SB_HEADS = 8
SB_HEAD_DIM = BRANCH_WIDTH // SB_HEADS
POOL_WINDOWS = (2, 4, 8, 16)
POOL_GROUPS = 4
POOL_GROUP = BRANCH_WIDTH // POOL_GROUPS
MEM_HEADS = 4
MEM_HEAD_DIM = BRANCH_WIDTH // MEM_HEADS
REL_BUCKETS = 32
REL_MAX_DIST = 128
Q_BLOCK = 128
EPS = 1e-6
N_SLICES = 12
IN_COLS = N_SLICES * BRANCH_WIDTH + N_BRANCH * D_MODEL

kernel_name = "hybrid_gated_diff_stickbreak_pool_mem"


def rmsnorm(x, g):
    xf = x.astype(jnp.float32)
    y = xf * lax.rsqrt(jnp.mean(xf * xf, axis=-1, keepdims=True) + EPS)
    return (y * g.astype(jnp.float32)).astype(x.dtype)


def t5_bucket(rel):
    n = jnp.maximum(rel, 0)
    max_exact = REL_BUCKETS // 2
    nf = jnp.maximum(n, 1).astype(jnp.float32)
    large = max_exact + (jnp.log(nf / max_exact) / math.log(REL_MAX_DIST / max_exact)
                         * (REL_BUCKETS - max_exact)).astype(jnp.int32)
    large = jnp.minimum(large, REL_BUCKETS - 1)
    return jnp.where(n < max_exact, n, large)


def to_blocks(t):
    b, s = t.shape[:2]
    t = t.reshape((b, s // Q_BLOCK, Q_BLOCK) + t.shape[2:])
    return jnp.moveaxis(t, 1, 0)


def from_blocks(t):
    t = jnp.moveaxis(t, 0, 1)
    return t.reshape((t.shape[0], -1) + t.shape[3:])


def diff_attention(q, k, v, rel_bias, lam):
    s_len = q.shape[1]
    k_pos = jnp.arange(s_len)
    scale = DA_QK_DIM ** -0.5

    def block(args):
        qb, start = args
        q_pos = start + jnp.arange(Q_BLOCK)
        rel = q_pos[:, None] - k_pos[None, :]
        bias = jnp.transpose(rel_bias[t5_bucket(rel)], (2, 0, 1)).astype(jnp.float32)
        logits = jnp.einsum('bqhcd,bkhcd->bhcqk', qb, k).astype(jnp.float32) * scale
        logits = logits + bias[None, :, None]
        logits = jnp.where(rel >= 0, logits, -jnp.inf)
        p = jax.nn.softmax(logits, axis=-1)
        a = p[:, :, 0] - lam * p[:, :, 1]
        return jnp.einsum('bhqk,bkhd->bqhd', a.astype(v.dtype), v)

    nb = s_len // Q_BLOCK
    out = lax.map(block, (to_blocks(q), jnp.arange(nb) * Q_BLOCK))
    return from_blocks(out)


def stick_breaking(q, k, v):
    s_len = q.shape[1]
    k_pos = jnp.arange(s_len)
    scale = SB_HEAD_DIM ** -0.5

    def block(args):
        qb, start = args
        q_pos = start + jnp.arange(Q_BLOCK)
        mask = k_pos[None, :] < q_pos[:, None]
        z = jnp.einsum('bqhd,bkhd->bhqk', qb, k).astype(jnp.float32) * scale
        log_beta = jax.nn.log_sigmoid(z)
        log_1mb = jnp.where(mask, jax.nn.log_sigmoid(-z), 0.0)
        between = lax.cumsum(log_1mb, axis=3, reverse=True) - log_1mb
        a = jnp.where(mask, jnp.exp(log_beta + between), 0.0)
        return jnp.einsum('bhqk,bkhd->bqhd', a.astype(v.dtype), v)

    nb = s_len // Q_BLOCK
    out = lax.map(block, (to_blocks(q), jnp.arange(nb) * Q_BLOCK))
    return from_blocks(out)


def multiscale_pool(u, w_pool, pool_scale):
    b, s, _ = u.shape
    ug = u.reshape(b, s, POOL_GROUPS, POOL_GROUP).astype(jnp.float32)
    c0 = jnp.concatenate([jnp.zeros((b, 1, POOL_GROUPS, POOL_GROUP), jnp.float32),
                          jnp.cumsum(ug, axis=1)], axis=1)
    t = jnp.arange(s)
    outs = []
    for g, w in enumerate(POOL_WINDOWS):
        cg = c0[:, :, g]
        lo = jnp.concatenate([jnp.zeros((b, w - 1, POOL_GROUP), jnp.float32),
                              cg[:, :s - w + 1]], axis=1)
        count = jnp.minimum(t + 1, w).astype(jnp.float32)[None, :, None]
        outs.append((cg[:, 1:] - lo) / count - ug[:, :, g])
    pooled = jnp.stack(outs, axis=2).astype(u.dtype)
    mixed = jnp.einsum('bsgc,gcd->bsgd', pooled, w_pool)
    return mixed.reshape(b, s, BRANCH_WIDTH) * pool_scale


def memory_attention(q, mk, mv):
    logits = jnp.einsum('bqhd,bmhd->bhqm', q, mk).astype(jnp.float32) * (MEM_HEAD_DIM ** -0.5)
    p = jax.nn.softmax(logits, axis=-1)
    return jnp.einsum('bhqm,bmhd->bqhd', p.astype(mv.dtype), mv)


def hybrid_layer(x, mem, layer_idx, rel_bias, norm_g, w_in, gate_b, lam_q1, lam_k1,
                 lam_q2, lam_k2, da_norm_g, w_pool, pool_scale, mem_norm_g, w_mem_kv,
                 w_branch, w_out):
    b, s, _ = x.shape
    h = rmsnorm(x, norm_g)
    proj = h @ w_in
    (da_q, da_k, da_v, da_z, sb_q, sb_k, sb_v, sb_z,
     pool_u, pool_z, mem_q, mem_z) = jnp.split(proj[..., :N_SLICES * BRANCH_WIDTH], N_SLICES, axis=-1)
    gate_logits = proj[..., N_SLICES * BRANCH_WIDTH:].reshape(b, s, N_BRANCH, D_MODEL) + gate_b

    lam_init = 0.8 - 0.6 * math.exp(-0.3 * layer_idx)
    lam = (jnp.exp(jnp.sum((lam_q1 * lam_k1).astype(jnp.float32)))
           - jnp.exp(jnp.sum((lam_q2 * lam_k2).astype(jnp.float32))) + lam_init)
    o_da = diff_attention(da_q.reshape(b, s, DA_HEADS, 2, DA_QK_DIM),
                          da_k.reshape(b, s, DA_HEADS, 2, DA_QK_DIM),
                          da_v.reshape(b, s, DA_HEADS, DA_V_DIM), rel_bias, lam)
    o_da = rmsnorm(o_da, da_norm_g.reshape(DA_HEADS, DA_V_DIM)) * (1.0 - lam_init)
    o_da = o_da.reshape(b, s, BRANCH_WIDTH)

    o_sb = stick_breaking(sb_q.reshape(b, s, SB_HEADS, SB_HEAD_DIM),
                          sb_k.reshape(b, s, SB_HEADS, SB_HEAD_DIM),
                          sb_v.reshape(b, s, SB_HEADS, SB_HEAD_DIM)).reshape(b, s, BRANCH_WIDTH)

    o_pool = multiscale_pool(pool_u, w_pool, pool_scale)

    mkv = rmsnorm(mem, mem_norm_g) @ w_mem_kv
    mk, mv = jnp.split(mkv, 2, axis=-1)
    m = mem.shape[1]
    o_mem = memory_attention(mem_q.reshape(b, s, MEM_HEADS, MEM_HEAD_DIM),
                             mk.reshape(b, m, MEM_HEADS, MEM_HEAD_DIM),
                             mv.reshape(b, m, MEM_HEADS, MEM_HEAD_DIM)).reshape(b, s, BRANCH_WIDTH)

    branches = (o_da * jax.nn.silu(da_z), o_sb * jax.nn.silu(sb_z),
                o_pool * jax.nn.silu(pool_z), o_mem * jax.nn.silu(mem_z))
    merged = jnp.zeros_like(x)
    for n in range(N_BRANCH):
        merged = merged + jax.nn.sigmoid(gate_logits[:, :, n]) * (branches[n] @ w_branch[n])
    return x + merged @ w_out


def setup_inputs(seed: int = 0) -> dict:
    key = jax.random.key(seed)
    ks = jax.random.split(key, 20)
    f32 = jnp.float32
    W = BRANCH_WIDTH
    nrm = lambda k, shape, s: jax.random.normal(k, shape, f32) * s
    return {
        "x": nrm(ks[0], (BATCH, SEQ, D_MODEL), 1.0),
        "mem": nrm(ks[1], (BATCH, N_MEM, D_MODEL), 1.0),
        "rel_bias": nrm(ks[2], (REL_BUCKETS, DA_HEADS), 0.5),
        "norm_g": 1.0 + nrm(ks[3], (DEPTH, D_MODEL), 0.02),
        "w_in": nrm(ks[4], (DEPTH, D_MODEL, IN_COLS), D_MODEL ** -0.5),
        "gate_b": nrm(ks[5], (DEPTH, N_BRANCH, D_MODEL), 0.02),
        "lam_q1": nrm(ks[6], (DEPTH, DA_QK_DIM), 0.1),
        "lam_k1": nrm(ks[7], (DEPTH, DA_QK_DIM), 0.1),
        "lam_q2": nrm(ks[8], (DEPTH, DA_QK_DIM), 0.1),
        "lam_k2": nrm(ks[9], (DEPTH, DA_QK_DIM), 0.1),
        "da_norm_g": 1.0 + nrm(ks[10], (DEPTH, W), 0.02),
        "w_pool": nrm(ks[11], (DEPTH, POOL_GROUPS, POOL_GROUP, POOL_GROUP), POOL_GROUP ** -0.5),
        "pool_scale": 1.0 + nrm(ks[12], (DEPTH, W), 0.1),
        "mem_norm_g": 1.0 + nrm(ks[13], (DEPTH, D_MODEL), 0.02),
        "w_mem_kv": nrm(ks[14], (DEPTH, D_MODEL, 2 * W), D_MODEL ** -0.5),
        "w_branch": nrm(ks[15], (DEPTH, N_BRANCH, W, D_MODEL), W ** -0.5),
        "w_out": nrm(ks[16], (DEPTH, D_MODEL, D_MODEL), D_MODEL ** -0.5),
        "final_g": 1.0 + nrm(ks[17], (D_MODEL,), 0.02),
    }


def reference(x, mem, rel_bias, norm_g, w_in, gate_b, lam_q1, lam_k1, lam_q2, lam_k2,
              da_norm_g, w_pool, pool_scale, mem_norm_g, w_mem_kv, w_branch, w_out, final_g):
    for l in range(DEPTH):
        x = hybrid_layer(x, mem, l, rel_bias, norm_g[l], w_in[l], gate_b[l], lam_q1[l], lam_k1[l],
                         lam_q2[l], lam_k2[l], da_norm_g[l], w_pool[l], pool_scale[l],
                         mem_norm_g[l], w_mem_kv[l], w_branch[l], w_out[l])
    return rmsnorm(x, final_g)
```

```cpp
#define PROBE_DUP 0
#include <hip/hip_runtime.h>
#include <hip/hip_cooperative_groups.h>
#include <cstdio>
#include <cstdint>
namespace cg = cooperative_groups;

namespace pg8 {
#define PG8_LAS __attribute__((address_space(3)))
typedef unsigned short bf16_t;
typedef short bf16x8 __attribute__((ext_vector_type(8)));
typedef float f32x4 __attribute__((ext_vector_type(4)));
typedef unsigned u32x4 __attribute__((ext_vector_type(4)));
typedef unsigned u32x2 __attribute__((ext_vector_type(2)));
constexpr int BM = 256, BK = 64, HALF = 128, HTB = HALF * BK * 2  , STAGE_BYTES = 8 * HTB, NXCD = 8, WGM = 8;

__host__ __device__ __forceinline__ int lds_byte(int r, int c) { const int st = (r >> 4) * 2 + (c >> 5), rr = r & 15, cc = c & 31, ob = rr * 64 + cc * 2; return st * 1024 + (ob ^ (((ob >> 9) & 1) << 5)); }
__host__ __device__ __forceinline__ void stage_rc(int b, int& R, int& C) { const int st = b / 1024, sb = b % 1024, swz = sb ^ (((sb >> 9) & 1) << 5); R = (st >> 1) * 16 + swz / 64; C = (st & 1) * 32 + (swz % 64) / 2; }
__host__ __device__ __forceinline__ int perm32(int rho) { const int n = rho >> 4, i = rho & 15; return 8 * (i >> 2) + 4 * n + (i & 3); }

__device__ __forceinline__ int lane_id() { int l; asm volatile("v_mbcnt_lo_u32_b32 %0, -1, 0\n\tv_mbcnt_hi_u32_b32 %0, -1, %0" : "=v"(l)); return l; }
struct Unit { int pm, pn, aux, om, on; };
struct Gemm { const bf16_t* A; const bf16_t* Bt; int M  , N, K; };

typedef float f32x2 __attribute__((ext_vector_type(2)));
typedef __bf16 bf16x2_t __attribute__((ext_vector_type(2)));
__device__ __forceinline__ unsigned cvt_pk_bf16(float lo, float hi) { f32x2 v = {lo, hi}; bf16x2_t b = __builtin_convertvector(v, bf16x2_t); return __builtin_bit_cast(unsigned, b); }

__device__ __forceinline__ void tile_swz(int L, int nM, int nN, int& pm, int& pn) {
    const int nwg = nM * nN; int wgid = L; { const int q = nwg / NXCD, r = nwg % NXCD, xcd = wgid % NXCD, off = wgid / NXCD; wgid = (xcd < r ? xcd * (q + 1) : r * (q + 1) + (xcd - r) * q) + off; }
    const int nig = WGM * nN, gid = wgid / nig, fm = gid * WGM, gsz = (nM - fm) < WGM ? (nM - fm) : WGM;
    pm = fm + ((wgid % nig) % gsz); pn = (wgid % nig) / gsz;
}
struct Sched2 {
    int nM, nN, G, c;
    __device__ __forceinline__ bool next(int i, Unit& u) const {
        const long L = (long)i * G + c; if (L >= nM * nN) return false;
        tile_swz((int)L, nM, nN, u.pm, u.pn); u.aux = 0; u.om = u.pm; u.on = u.pn; return true;
    }
    __device__ __forceinline__ void a_ready(const Unit&) const {}
    __device__ __forceinline__ void done(const Unit&) const {}
};
struct SchedP1 {
    int TH, TW, G, c;
    __device__ __forceinline__ bool next(int i, Unit& u) const {
        long L = (long)i * G + c;
        if (L < 64 * 72) { tile_swz((int)L, 64, 72, u.om, u.on); u.pm = TH + u.om; u.pn = TW + u.on; u.aux = 0; return true; }
        L -= 64 * 72; if (L < 8 * 64) { tile_swz((int)L, 8, 64, u.om, u.on); u.pm = TW + 76 + u.om; u.pn = TH + u.on; u.aux = 1; return true; }
        return false;
    }
    __device__ __forceinline__ void a_ready(const Unit&) const {}
    __device__ __forceinline__ void done(const Unit&) const {}
};
struct SchedMem {
    int TM, TW0, TWL, G, c;
    __device__ __forceinline__ bool next(int i, Unit& u) const {
        const long L = (long)i * G + c; if (L >= 64) return false;
        const int l2 = (int)L >> 5, t = ((int)L >> 4) & 1, ii = ((int)L >> 2) & 3, jj = (int)L & 3, tw = TW0 + TWL * l2, tm = TM + 4 * l2;
        if (t == 0) { u.pm = tm + ii; u.pn = tw + 72 + jj; } else { u.pm = tw + 84 + ii; u.pn = tm + jj; }
        u.aux = 2 + l2 * 2 + t; u.om = ii; u.on = jj; return true;
    }
    __device__ __forceinline__ void a_ready(const Unit&) const {}
    __device__ __forceinline__ void done(const Unit&) const {}
};
struct SchedBranch {
    int G, c;
    __device__ __forceinline__ bool next(int i, Unit& u) const {
        const int n = i & 3; const long T = (long)(i >> 2) * G + c; if (T >= 512) return false;
        int pm, pn; tile_swz((int)T, 64, 8, pm, pn); u.pm = n * 64 + pm; u.pn = n * 8 + pn; u.aux = n; u.om = pm; u.on = pn; return true;
    }
    __device__ __forceinline__ void a_ready(const Unit&) const {}
    __device__ __forceinline__ void done(const Unit&) const {}
};
struct SchedPool {
    int G, c;
    __device__ __forceinline__ bool next(int i, Unit& u) const {
        const long L = (long)i * G + c; if (L >= 256) return false; u.pm = (int)L; u.pn = (int)L >> 6; u.aux = (int)L >> 6; u.om = (int)L & 63; u.on = 0; return true;
    }
    __device__ __forceinline__ void a_ready(const Unit&) const {}
    __device__ __forceinline__ void done(const Unit&) const {}
};
template <class Epi, class Sched, bool ALIGN_EPI = false, bool SP2 = false>
__device__ __forceinline__ void gemm_phase(PG8_LAS unsigned char* lds, const Gemm g, const Sched& S, const Epi& E) {
    const int tid_ = g.M * 64 + lane_id();
    const int tid = tid_, wid = __builtin_amdgcn_readfirstlane(tid >> 6), lane = tid & 63, wr = wid >> 2, wc = wid & 3, fr = lane & 15, fq = lane >> 4;
    const int K = g.K, nt = K / BK;
    unsigned voffA[2], voffB[2];
#pragma unroll
    for (int i = 0; i < 2; ++i) { int R, C; stage_rc(tid * 16 + i * 8192, R, C); const int Rb = Epi::PERM ? ((R & ~31) + perm32(R & 31)) : R;
        voffA[i] = (unsigned)(R * K + C) * 2u; voffB[i] = (unsigned)(Rb * K + C) * 2u; }
    const size_t kstep = (size_t)(BK * 2);
    const size_t hstep = (size_t)HALF * K * 2;
    const size_t tstep = 2 * hstep;
    const unsigned ldsw = (unsigned)wid * 1024u;
    const int aoff = lds_byte(wr * 64 + fr, fq * 8), boff = lds_byte(wc * 32 + fr, fq * 8);
#define PG8_SA(b, h) (((b) * 2 + (h)) * HTB)
#define PG8_SB(b, h) ((4 + (b) * 2 + (h)) * HTB)
#define PG8_STAGE(bufoff, gbase, voff) do { _Pragma("unroll") for (int _i = 0; _i < 2; ++_i) \
        __builtin_amdgcn_global_load_lds((const unsigned*)((const char*)(gbase) + (voff)[_i]), (PG8_LAS unsigned*)(lds + (bufoff) + ldsw + _i * 8192), 16, 0, 0); } while (0)
#define PG8_LDA(dst, b, h) do { _Pragma("unroll") for (int m = 0; m < 4; ++m) _Pragma("unroll") for (int k = 0; k < 2; ++k) dst[m][k] = *(const PG8_LAS bf16x8*)(lds + PG8_SA(b, h) + aoff + m * 2048 + k * 1024); } while (0)
#define PG8_LDB(dst, b, h) do { _Pragma("unroll") for (int n = 0; n < 2; ++n) _Pragma("unroll") for (int k = 0; k < 2; ++k) dst[n][k] = *(const PG8_LAS bf16x8*)(lds + PG8_SB(b, h) + boff + n * 2048 + k * 1024); } while (0)
#define PG8_MMA(ai, bj, At, Bt) do { __builtin_amdgcn_s_setprio(1); _Pragma("unroll") for (int m = 0; m < 4; ++m) _Pragma("unroll") for (int n = 0; n < 2; ++n) _Pragma("unroll") for (int k = 0; k < 2; ++k) \
        acc[ai][bj][m][n] = __builtin_amdgcn_mfma_f32_16x16x32_bf16(Bt[n][k], At[m][k], acc[ai][bj][m][n], 0, 0, 0); __builtin_amdgcn_s_setprio(0); } while (0)
#define PG8_WAIT_V(n) asm volatile("s_waitcnt vmcnt(" #n ")" ::: "memory")
#define PG8_WAIT_L(n) asm volatile("s_waitcnt lgkmcnt(" #n ")" ::: "memory")
#define PG8_BAR __builtin_amdgcn_s_barrier()
#define PG8_SCHED __builtin_amdgcn_sched_barrier(0)
    Unit cur, nxt; int ui = 0;
    if (!S.next(0, cur)) return;
    f32x4 acc[2][2][4][2];
#pragma unroll
    for (int a = 0; a < 2; ++a)
#pragma unroll
        for (int b = 0; b < 2; ++b)
#pragma unroll
            for (int m = 0; m < 4; ++m)
#pragma unroll
                for (int n = 0; n < 2; ++n) acc[a][b][m][n] = (f32x4){0.f, 0.f, 0.f, 0.f};
    bf16x8 At[4][2], B0[2][2], B1[2][2];
    const char* cA = (const char*)g.A + (size_t)cur.pm * tstep; const char* cB = (const char*)g.Bt + (size_t)cur.pn * tstep;
    S.a_ready(cur);
    if constexpr (SP2) {
        PG8_STAGE(PG8_SB(0, 0), cB, voffB); PG8_STAGE(PG8_SB(0, 1), cB + hstep, voffB); PG8_STAGE(PG8_SA(0, 0), cA, voffA); PG8_STAGE(PG8_SA(0, 1), cA + hstep, voffA);
        if (wr == 1) PG8_BAR;
        PG8_WAIT_V(2); PG8_BAR;
        PG8_STAGE(PG8_SB(1, 0), cB + kstep, voffB); PG8_STAGE(PG8_SA(1, 0), cA + kstep, voffA); PG8_STAGE(PG8_SB(1, 1), cB + hstep + kstep, voffB);
        PG8_WAIT_V(6); PG8_BAR;
    } else {
        PG8_STAGE(PG8_SB(0, 0), cB, voffB); PG8_STAGE(PG8_SA(0, 0), cA, voffA); PG8_STAGE(PG8_SB(0, 1), cB + hstep, voffB); PG8_STAGE(PG8_SA(0, 1), cA + hstep, voffA);
        if (wr == 1) PG8_BAR;
        PG8_WAIT_V(4); PG8_BAR;
        PG8_STAGE(PG8_SB(1, 0), cB + kstep, voffB); PG8_STAGE(PG8_SA(1, 0), cA + kstep, voffA); PG8_STAGE(PG8_SB(1, 1), cB + hstep + kstep, voffB);
        PG8_WAIT_V(6); PG8_BAR;
    }
    for (;;) {
        const bool has_next = S.next(ui + 1, nxt);
        const char* nA = has_next ? (const char*)g.A + (size_t)nxt.pm * tstep : cA; const char* nB = has_next ? (const char*)g.Bt + (size_t)nxt.pn * tstep : cB;
        for (int t = 0; t < nt; t += 2) {
            const bool last = (t == nt - 2);
            const char* a1 = cA + (size_t)(t + 1) * kstep;
            const char* a2 = last ? nA : cA + (size_t)(t + 2) * kstep; const char* b2 = last ? nB : cB + (size_t)(t + 2) * kstep;
            const char* a3 = a2 + kstep; const char* b3 = b2 + kstep;
            if (last && has_next) S.a_ready(nxt);
            if constexpr (SP2) {
            PG8_LDB(B0, 0, 0); PG8_LDB(B1, 0, 1); PG8_SCHED; PG8_LDA(At, 0, 0); PG8_STAGE(PG8_SA(1, 1), a1 + hstep, voffA);
            PG8_WAIT_V(8); PG8_WAIT_L(0); PG8_BAR; PG8_MMA(0, 0, At, B0); PG8_MMA(0, 1, At, B1); PG8_BAR; PG8_SCHED;
            PG8_LDA(At, 0, 1); PG8_STAGE(PG8_SB(0, 0), b2, voffB); PG8_STAGE(PG8_SB(0, 1), b2 + hstep, voffB); PG8_STAGE(PG8_SA(0, 0), a2, voffA);
            PG8_WAIT_V(8); PG8_WAIT_L(0); PG8_BAR; PG8_MMA(1, 0, At, B0); PG8_MMA(1, 1, At, B1); PG8_BAR; PG8_SCHED;
            PG8_LDB(B0, 1, 0); PG8_LDB(B1, 1, 1); PG8_SCHED; PG8_LDA(At, 1, 0); PG8_STAGE(PG8_SA(0, 1), a2 + hstep, voffA);
            PG8_WAIT_V(8); PG8_WAIT_L(0); PG8_BAR; PG8_MMA(0, 0, At, B0); PG8_MMA(0, 1, At, B1); PG8_BAR; PG8_SCHED;
            PG8_LDA(At, 1, 1); PG8_STAGE(PG8_SB(1, 0), b3, voffB); PG8_STAGE(PG8_SB(1, 1), b3 + hstep, voffB); PG8_STAGE(PG8_SA(1, 0), a3, voffA);
            PG8_WAIT_V(8); PG8_WAIT_L(0); PG8_BAR; PG8_MMA(1, 0, At, B0); PG8_MMA(1, 1, At, B1); PG8_BAR; PG8_SCHED;
            } else {
            PG8_LDB(B0, 0, 0); PG8_SCHED; PG8_LDA(At, 0, 0); PG8_STAGE(PG8_SA(1, 1), a1 + hstep, voffA);
            PG8_WAIT_L(8); PG8_BAR; PG8_WAIT_L(0); PG8_MMA(0, 0, At, B0); PG8_BAR; PG8_SCHED;
            PG8_LDB(B1, 0, 1); PG8_STAGE(PG8_SB(0, 0), b2, voffB);
            PG8_BAR; PG8_WAIT_L(0); PG8_MMA(0, 1, At, B1); PG8_BAR;
            PG8_LDA(At, 0, 1); PG8_STAGE(PG8_SA(0, 0), a2, voffA);
            PG8_BAR; PG8_WAIT_L(0); PG8_MMA(1, 0, At, B0); PG8_BAR; PG8_SCHED;
            PG8_STAGE(PG8_SB(0, 1), b2 + hstep, voffB);
            PG8_WAIT_V(6); PG8_BAR; PG8_MMA(1, 1, At, B1); PG8_BAR;
            PG8_LDB(B0, 1, 0); PG8_SCHED; PG8_LDA(At, 1, 0); PG8_STAGE(PG8_SA(0, 1), a2 + hstep, voffA);
            PG8_WAIT_L(8); PG8_BAR; PG8_WAIT_L(0); PG8_MMA(0, 0, At, B0); PG8_BAR; PG8_SCHED;
            PG8_LDB(B1, 1, 1); PG8_STAGE(PG8_SB(1, 0), b3, voffB);
            PG8_BAR; PG8_WAIT_L(0); PG8_MMA(0, 1, At, B1); PG8_BAR;
            PG8_LDA(At, 1, 1); PG8_STAGE(PG8_SA(1, 0), a3, voffA);
            PG8_BAR; PG8_WAIT_L(0); PG8_MMA(1, 0, At, B0); PG8_BAR; PG8_SCHED;
            PG8_STAGE(PG8_SB(1, 1), b3 + hstep, voffB);
            PG8_WAIT_V(6); PG8_BAR; PG8_MMA(1, 1, At, B1); PG8_BAR;
            }
        }
        if constexpr (ALIGN_EPI) { if (wr == 0) PG8_BAR; }
        if constexpr (!Epi::AFTER_DRAIN) { E(acc, cur, wr, wc, fr, fq); S.done(cur); }
        if (!has_next) break;
        if (!(Epi::CHAIN && cur.aux < 3))
#pragma unroll
        for (int a = 0; a < 2; ++a)
#pragma unroll
            for (int b = 0; b < 2; ++b)
#pragma unroll
                for (int m = 0; m < 4; ++m)
#pragma unroll
                    for (int n = 0; n < 2; ++n) acc[a][b][m][n] = (f32x4){0.f, 0.f, 0.f, 0.f};
        cur = nxt; cA = nA; cB = nB; ++ui;
        if constexpr (ALIGN_EPI) { if (wr == 1) PG8_BAR; }
    }
    PG8_WAIT_V(0);
    if constexpr (!ALIGN_EPI) { if (wr == 0) PG8_BAR; }
    PG8_BAR;
    if constexpr (Epi::AFTER_DRAIN) { E.fused(acc, cur, wr, wc, fr, fq, lds, wid, lane); S.done(cur); }
#undef PG8_SA
#undef PG8_SB
#undef PG8_STAGE
#undef PG8_LDA
#undef PG8_LDB
#undef PG8_MMA
#undef PG8_WAIT_V
#undef PG8_WAIT_L
#undef PG8_BAR
#undef PG8_SCHED
}
}

constexpr int DM = 2048, NB = 4, SEQ = 4096, NTOK = NB * SEQ, NMEM = 256, NMEMTOK = NB * NMEM, BW = 1024, DEPTH = 2;
constexpr int INC = 20480;
constexpr int LDP = 18432, C_DAQ = 0, C_DAK = 1024, C_SBQ = 2048, C_SBK = 3072, C_MEMQ = 4096, C_POOLU = 5120, C_DAZ = 6144, C_SBZ = 7168, C_POOLZ = 8192, C_MEMZ = 9216, C_GATE = 10240;
constexpr int R_MK = 18432, R_V = 19456, R_MV = 21504, R_END = 22528;
constexpr float EPS = 1e-6f, LOG2E = 1.4426950408889634f;
constexpr size_t MiB = 1u << 20;
constexpr size_t WS_CTL = 0, WS_WT = 2 * MiB, WT_LAYER = 113 * MiB, WT_BR = 88 * MiB, WT_OUT = 104 * MiB, WT_POOL = 112 * MiB;
constexpr size_t WS_H = 228 * MiB, WS_P = 296 * MiB, WS_VT = 872 * MiB, WS_MK = 936 * MiB, WS_MVT = 938 * MiB, WS_POOLED = 940 * MiB, WS_BR = 972 * MiB, WS_TMP = 1100 * MiB, WS_MEMN = 1228 * MiB, WS_MKV = 1236 * MiB, WS_END = 1244 * MiB;
constexpr int CTL_BAR = 4096  , CTL_ZERO_BYTES = 65536;
constexpr int CTL_Q = 0  , CTL_BTAB = 1024  , CTL_LAM = 2560  ;
constexpr int BT_STRIDE = 132;

namespace pg8 {
__device__ __forceinline__ float bflo(unsigned w) { return __uint_as_float(w << 16); }
__device__ __forceinline__ float bfhi(unsigned w) { return __uint_as_float(w & 0xffff0000u); }
__device__ __forceinline__ float silu_f(float z) { return z * __builtin_amdgcn_rcpf(1.f + __builtin_amdgcn_exp2f(-z * LOG2E)); }
__device__ __forceinline__ float sigm_f(float z) { return __builtin_amdgcn_rcpf(1.f + __builtin_amdgcn_exp2f(-z * LOG2E)); }
struct EpiP1 {
    static constexpr bool PERM = true, AFTER_DRAIN = false, CHAIN = false;
    unsigned char* ws; const float* gate_b; int wv;
    __device__ __forceinline__ void operator()(const f32x4 (&acc)[2][2][4][2], const Unit& u, int wr_, int wc_, int fr_, int fq_) const {
        const int l_ = lane_id(), wid_ = wv, wr = wid_ >> 2, wc = wid_ & 3, fr = l_ & 15, fq = l_ >> 4; (void)wr_; (void)wc_; (void)fr_; (void)fq_;
        bf16_t* base = (bf16_t*)(ws + (u.aux == 0 ? WS_P : u.aux == 1 ? WS_VT : WS_MKV + (size_t)(u.aux - 2) * 2 * MiB));
        const int ldc = u.aux == 0 ? LDP : u.aux == 1 ? NTOK : NMEMTOK;
        const int row0 = u.om * BM + wr * 64 + fr, col0 = u.on * BM + wc * 32 + 8 * fq;
        if ((u.aux == 0) && (u.on >= C_GATE / BM)) {
            f32x4 gbv[2][2];
#pragma unroll
            for (int bj = 0; bj < 2; ++bj) { const float* gb = gate_b + (col0 + bj * HALF - C_GATE); gbv[bj][0] = *(const f32x4*)gb; gbv[bj][1] = *(const f32x4*)(gb + 4); }
#pragma unroll
            for (int ai = 0; ai < 2; ++ai)
#pragma unroll
                for (int m = 0; m < 4; ++m) { bf16_t* rowp = base + (size_t)(row0 + ai * HALF + m * 16) * ldc + col0;
#pragma unroll
                    for (int bj = 0; bj < 2; ++bj) { f32x4 v0 = acc[ai][bj][m][0], v1 = acc[ai][bj][m][1];
#pragma unroll
                        for (int i = 0; i < 4; ++i) { v0[i] = sigm_f(fmaxf(v0[i] + gbv[bj][0][i], -30.f)); v1[i] = sigm_f(fmaxf(v1[i] + gbv[bj][1][i], -30.f)); }
                        u32x4 w; w.x = cvt_pk_bf16(v0[0], v0[1]); w.y = cvt_pk_bf16(v0[2], v0[3]); w.z = cvt_pk_bf16(v1[0], v1[1]); w.w = cvt_pk_bf16(v1[2], v1[3]);
                        *(u32x4*)(rowp + bj * HALF) = w; } }
        } else {
#pragma unroll
            for (int ai = 0; ai < 2; ++ai)
#pragma unroll
                for (int m = 0; m < 4; ++m) { bf16_t* rowp = base + (size_t)(row0 + ai * HALF + m * 16) * ldc + col0;
#pragma unroll
                    for (int bj = 0; bj < 2; ++bj) { const f32x4 v0 = acc[ai][bj][m][0], v1 = acc[ai][bj][m][1];
                        u32x4 w; w.x = cvt_pk_bf16(v0[0], v0[1]); w.y = cvt_pk_bf16(v0[2], v0[3]); w.z = cvt_pk_bf16(v1[0], v1[1]); w.w = cvt_pk_bf16(v1[2], v1[3]);
                        *(u32x4*)(rowp + bj * HALF) = w; } }
        }
    }
};
struct EpiPool {
    static constexpr bool PERM = true, AFTER_DRAIN = false, CHAIN = false;
    const bf16_t* P; const float* pscale; bf16_t* br2; int wv;
    __device__ __forceinline__ void operator()(const f32x4 (&acc)[2][2][4][2], const Unit& u, int wr_, int wc_, int fr_, int fq_) const {
        const int l_ = lane_id(), wid_ = wv, wr = wid_ >> 2, wc = wid_ & 3, fr = l_ & 15, fq = l_ >> 4; (void)wr_; (void)wc_; (void)fr_; (void)fq_;
        const int g = u.aux, row0 = (u.pm - 64 * g) * BM + wr * 64 + fr, colb = wc * 32 + 8 * fq;
        f32x4 sc[2][2];
#pragma unroll
        for (int bj = 0; bj < 2; ++bj) { sc[bj][0] = *(const f32x4*)(pscale + g * 256 + colb + bj * HALF); sc[bj][1] = *(const f32x4*)(pscale + g * 256 + colb + bj * HALF + 4); }
#pragma unroll
        for (int ai = 0; ai < 2; ++ai) {
            u32x4 zz[4][2];
#pragma unroll
            for (int m = 0; m < 4; ++m)
#pragma unroll
                for (int bj = 0; bj < 2; ++bj) zz[m][bj] = *(const u32x4*)(P + (size_t)(row0 + ai * HALF + m * 16) * LDP + C_POOLZ + g * 256 + colb + bj * HALF);
#pragma unroll
            for (int m = 0; m < 4; ++m) { const int tok = row0 + ai * HALF + m * 16;
#pragma unroll
                for (int bj = 0; bj < 2; ++bj) { const int ch = g * 256 + colb + bj * HALF;
                    const u32x4 z = zz[m][bj]; const f32x4 s0 = sc[bj][0], s1 = sc[bj][1];
                    const f32x4 v0 = acc[ai][bj][m][0], v1 = acc[ai][bj][m][1];
                    u32x4 w;
                    w.x = cvt_pk_bf16(v0[0] * s0[0] * silu_f(bflo(z.x)), v0[1] * s0[1] * silu_f(bfhi(z.x)));
                    w.y = cvt_pk_bf16(v0[2] * s0[2] * silu_f(bflo(z.y)), v0[3] * s0[3] * silu_f(bfhi(z.y)));
                    w.z = cvt_pk_bf16(v1[0] * s1[0] * silu_f(bflo(z.z)), v1[1] * s1[1] * silu_f(bfhi(z.z)));
                    w.w = cvt_pk_bf16(v1[2] * s1[2] * silu_f(bflo(z.w)), v1[3] * s1[3] * silu_f(bfhi(z.w)));
                    *(u32x4*)(br2 + (size_t)tok * BW + ch) = w; } }
            asm volatile("" ::: "memory"); }
    }
};
struct EpiMergeChain {
    static constexpr bool PERM = true, AFTER_DRAIN = false, CHAIN = true;
    const bf16_t* P; bf16_t* merged; int wv;
    __device__ __forceinline__ void operator()(f32x4 (&acc)[2][2][4][2], const Unit& u, int wr_, int wc_, int fr_, int fq_) const {
        const int l_ = lane_id(), wid_ = wv, wr = wid_ >> 2, wc = wid_ & 3, fr = l_ & 15, fq = l_ >> 4; (void)wr_; (void)wc_; (void)fr_; (void)fq_;
        const int n = u.aux, row0 = u.om * BM + wr * 64 + fr, col0 = u.on * BM + wc * 32 + 8 * fq;
        const bf16_t* gbase = P + (size_t)row0 * LDP + C_GATE + n * DM + col0;
        if (n < 3) {
#pragma unroll
            for (int ai = 0; ai < 2; ++ai) {
                u32x4 gaa[4][2], gbb[4][2];
#pragma unroll
                for (int m = 0; m < 4; ++m)
#pragma unroll
                    for (int bj = 0; bj < 2; ++bj) { const bf16_t* gp = gbase + (size_t)(ai * HALF + m * 16) * LDP + bj * HALF; gaa[m][bj] = *(const u32x4*)gp; gbb[m][bj] = *(const u32x4*)(gp + DM); }
#pragma unroll
                for (int m = 0; m < 4; ++m)
#pragma unroll
                    for (int bj = 0; bj < 2; ++bj) { const u32x4 ga = gaa[m][bj], gb = gbb[m][bj]; f32x4 a0 = acc[ai][bj][m][0], a1 = acc[ai][bj][m][1];
                        a0[0] *= bflo(ga.x) * __builtin_amdgcn_rcpf(bflo(gb.x)); a0[1] *= bfhi(ga.x) * __builtin_amdgcn_rcpf(bfhi(gb.x));
                        a0[2] *= bflo(ga.y) * __builtin_amdgcn_rcpf(bflo(gb.y)); a0[3] *= bfhi(ga.y) * __builtin_amdgcn_rcpf(bfhi(gb.y));
                        a1[0] *= bflo(ga.z) * __builtin_amdgcn_rcpf(bflo(gb.z)); a1[1] *= bfhi(ga.z) * __builtin_amdgcn_rcpf(bfhi(gb.z));
                        a1[2] *= bflo(ga.w) * __builtin_amdgcn_rcpf(bflo(gb.w)); a1[3] *= bfhi(ga.w) * __builtin_amdgcn_rcpf(bfhi(gb.w));
                        acc[ai][bj][m][0] = a0; acc[ai][bj][m][1] = a1; }
                asm volatile("" ::: "memory"); }
        } else {
#pragma unroll
            for (int ai = 0; ai < 2; ++ai) {
                u32x4 gaa[4][2];
#pragma unroll
                for (int m = 0; m < 4; ++m)
#pragma unroll
                    for (int bj = 0; bj < 2; ++bj) gaa[m][bj] = *(const u32x4*)(gbase + (size_t)(ai * HALF + m * 16) * LDP + bj * HALF);
#pragma unroll
                for (int m = 0; m < 4; ++m)
#pragma unroll
                    for (int bj = 0; bj < 2; ++bj) { const u32x4 ga = gaa[m][bj]; const f32x4 a0 = acc[ai][bj][m][0], a1 = acc[ai][bj][m][1];
                        u32x4 w; w.x = cvt_pk_bf16(a0[0] * bflo(ga.x), a0[1] * bfhi(ga.x)); w.y = cvt_pk_bf16(a0[2] * bflo(ga.y), a0[3] * bfhi(ga.y));
                        w.z = cvt_pk_bf16(a1[0] * bflo(ga.z), a1[1] * bfhi(ga.z)); w.w = cvt_pk_bf16(a1[2] * bflo(ga.w), a1[3] * bfhi(ga.w));
                        *(u32x4*)(merged + (size_t)(row0 + ai * HALF + m * 16) * DM + col0 + bj * HALF) = w; }
                asm volatile("" ::: "memory"); }
        }
    }
};
struct EpiOut {
    static constexpr bool PERM = true, AFTER_DRAIN = false, CHAIN = false;
    const float* xin; float* xout; int wv;
    __device__ __forceinline__ void operator()(const f32x4 (&acc)[2][2][4][2], const Unit& u, int wr_, int wc_, int fr_, int fq_) const {
        const int l_ = lane_id(), wid_ = wv, wr = wid_ >> 2, wc = wid_ & 3, fr = l_ & 15, fq = l_ >> 4; (void)wr_; (void)wc_; (void)fr_; (void)fq_;
        const int row0 = u.pm * BM + wr * 64 + fr, col0 = u.pn * BM + wc * 32 + 8 * fq;
#pragma unroll
        for (int ai = 0; ai < 2; ++ai) {
            f32x4 xr[4][2][2];
#pragma unroll
            for (int m = 0; m < 4; ++m)
#pragma unroll
                for (int bj = 0; bj < 2; ++bj) { const size_t off = (size_t)(row0 + ai * HALF + m * 16) * DM + col0 + bj * HALF; xr[m][bj][0] = *(const f32x4*)(xin + off); xr[m][bj][1] = *(const f32x4*)(xin + off + 4); }
#pragma unroll
            for (int m = 0; m < 4; ++m)
#pragma unroll
                for (int bj = 0; bj < 2; ++bj) { const size_t off = (size_t)(row0 + ai * HALF + m * 16) * DM + col0 + bj * HALF;
                    *(f32x4*)(xout + off) = xr[m][bj][0] + acc[ai][bj][m][0]; *(f32x4*)(xout + off + 4) = xr[m][bj][1] + acc[ai][bj][m][1]; }
            asm volatile("" ::: "memory"); }
    }
};
}

#define LAS __attribute__((address_space(3)))
typedef unsigned short bf16_t;
typedef short bf16x8 __attribute__((ext_vector_type(8)));
typedef float f32x4 __attribute__((ext_vector_type(4)));
typedef float f32x16 __attribute__((ext_vector_type(16)));
typedef unsigned u32x4 __attribute__((ext_vector_type(4)));
typedef unsigned u32x2 __attribute__((ext_vector_type(2)));
using pg8::cvt_pk_bf16; using pg8::bflo; using pg8::bfhi; using pg8::silu_f;
constexpr int NWAVES = 8, NTHR = 512;
constexpr int RING_BYTES = 131072, MISC_OFF = RING_BYTES, LDS_BYTES = 147456;
#define LDS_WAIT() asm volatile("s_waitcnt lgkmcnt(0)" ::: "memory")

struct Params {
    const float* x; const float* mem; const float* rel_bias; const float* norm_g; const float* w_in; const float* gate_b;
    const float* lq1; const float* lk1; const float* lq2; const float* lk2; const float* da_norm_g; const float* w_pool; const float* pool_scale;
    const float* mem_norm_g; const float* w_mem_kv; const float* w_branch; const float* w_out; const float* final_g;
    float* out; unsigned char* ws;
};

#define GAS __attribute__((address_space(1)))
#define XB_TMO      128
#define XB_XCNT(j)  (256  + 64 * (j))
#define XB_XSUB(j)  (1280 + 64 * (j))
#define XB_XGEN(j)  (2304 + 64 * (j))
#define XB_TOP      3328
#define XB_TOPGEN   3392
#define XCD_BAR_WORDS 3456
#define XB_SPIN_CAP (1u << 18)

__device__ __forceinline__ unsigned xb_ld(unsigned* p)              { return __hip_atomic_load(p, __ATOMIC_RELAXED, __HIP_MEMORY_SCOPE_AGENT); }
__device__ __forceinline__ unsigned xb_add(unsigned* p, unsigned v) { return __hip_atomic_fetch_add(p, v, __ATOMIC_RELAXED, __HIP_MEMORY_SCOPE_AGENT); }
__device__ __forceinline__ unsigned xb_xcc_id() { return (unsigned)__builtin_amdgcn_s_getreg((3 << 11) | 20) & 0xFu; }
#define XB_SPIN(cond, bar) do { unsigned _sp = 0; while (cond) { __builtin_amdgcn_s_sleep(1); \
    if ((++_sp & 255u) == 0u) { if (xb_ld(&(bar)[XB_TMO])) break; if (_sp > XB_SPIN_CAP) { atomicAdd(&(bar)[XB_TMO], 1u); break; } } } } while (0)

struct XcdBarrier {
    unsigned* bar; unsigned x; int wv;
    volatile LAS unsigned* st;
};

__device__ __forceinline__ XcdBarrier xcd_barrier_post(unsigned* bar, volatile LAS unsigned* st) {
    XcdBarrier b; b.bar = bar; b.x = xb_xcc_id(); b.st = st;
    if (threadIdx.x == 0) (void)xb_add(&bar[XB_XCNT(b.x)], 1u);
    return b;
}
__device__ __forceinline__ void xcd_barrier_complete(unsigned* bar, unsigned x, unsigned& nloc, unsigned& nx) {
    const unsigned G = gridDim.x * gridDim.y * gridDim.z;
    unsigned sum, cnt, mine, sp = 0u;
    for (;;) {
        sum = 0u; cnt = 0u; mine = 0u;
#pragma unroll
        for (unsigned j = 0; j < 16; ++j) { const unsigned c = xb_ld(&bar[XB_XCNT(j)]); sum += c; cnt += (c > 0u) ? 1u : 0u; mine = (j == x) ? c : mine; }
        if (sum == G) break;
        __builtin_amdgcn_s_sleep(1);
        if ((++sp & 255u) == 0u) { if (xb_ld(&bar[XB_TMO])) break; if (sp > XB_SPIN_CAP) { atomicAdd(&bar[XB_TMO], 1u); break; } }
    }
    nloc = mine > 0u ? mine : 1u; nx = cnt > 0u ? cnt : 1u;
}

__device__ __forceinline__ void xcd_barrier(const XcdBarrier& b) {
    asm volatile("s_waitcnt vmcnt(0)" ::: "memory");
    __syncthreads();
    if (b.wv == 0 && pg8::lane_id() == 0) {
        unsigned* bar = b.bar;
        __builtin_amdgcn_s_waitcnt(0);
        unsigned nloc = b.st[0], nx = b.st[1];
        if (nloc == 0u) { xcd_barrier_complete(bar, b.x, nloc, nx); b.st[0] = nloc; b.st[1] = nx; }
        const unsigned old = xb_add(&bar[XB_XSUB(b.x)], 1u);
        const unsigned gen = old / nloc;
        if (old + 1u == (gen + 1u) * nloc) {
            __builtin_amdgcn_fence(__ATOMIC_RELEASE, "agent");
            asm volatile("s_waitcnt vmcnt(0)" ::: "memory");
            const unsigned og = xb_add(&bar[XB_TOP], 1u);
            const unsigned tg = og / nx;
            if (og + 1u == (tg + 1u) * nx) xb_add(&bar[XB_TOPGEN], 1u);
            else XB_SPIN(xb_ld(&bar[XB_TOPGEN]) == tg, bar);
            __builtin_amdgcn_fence(__ATOMIC_ACQUIRE, "agent");
            xb_add(&bar[XB_XGEN(b.x)], 1u);
            asm volatile("s_waitcnt vmcnt(0)" ::: "memory");
        } else {
            XB_SPIN(xb_ld(&bar[XB_XGEN(b.x)]) == gen, bar);
            __builtin_amdgcn_fence(__ATOMIC_ACQUIRE, "agent");
            asm volatile("s_waitcnt vmcnt(0)" ::: "memory");
        }
    }
    __syncthreads();
}

__device__ __forceinline__ const Params* kparams() { auto kp = __builtin_amdgcn_kernarg_segment_ptr(); asm volatile("" : "+s"(kp)); return (const Params*)kp; }
__device__ __forceinline__ float wave_sum(float v, int lane) {
#pragma unroll
    for (int o = 1; o < 64; o <<= 1) v += __int_as_float(__builtin_amdgcn_ds_bpermute((lane ^ o) << 2, __float_as_int(v)));
    return v;
}
__device__ __forceinline__ void transpose_item(const float* W, int K, int N, bf16_t* WT, long row_off, LAS float* scr, int kb, int nb, int lane) {
    const int k0 = 64 * kb, n0 = 32 * nb;
    float wv[32];
#pragma unroll
    for (int i = 0; i < 32; ++i) wv[i] = W[(size_t)(k0 + 2 * i + (lane >> 5)) * N + n0 + (lane & 31)];
#pragma unroll
    for (int i = 0; i < 32; ++i) scr[(2 * i + (lane >> 5)) * 33 + (lane & 31)] = wv[i];
    LDS_WAIT(); asm volatile("" ::: "memory");
    const int c = lane & 7;
#pragma unroll
    for (int j = 0; j < 4; ++j) { const int n = (lane >> 3) + 8 * j; const LAS float* s = scr + (8 * c) * 33 + n;
        u32x4 o; o.x = cvt_pk_bf16(s[0 * 33], s[1 * 33]); o.y = cvt_pk_bf16(s[2 * 33], s[3 * 33]); o.z = cvt_pk_bf16(s[4 * 33], s[5 * 33]); o.w = cvt_pk_bf16(s[6 * 33], s[7 * 33]);
        *(u32x4*)(WT + (size_t)(row_off + n0 + n) * K + k0 + 8 * c) = o; }
    LDS_WAIT(); asm volatile("" ::: "memory");
}
__device__ __forceinline__ int win_dest_row(int n0) {
    if (n0 >= 12288) return C_GATE + (n0 - 12288);
    const int s = n0 >> 10, r = n0 & 1023;
    const int base = s == 0 ? C_DAQ : s == 1 ? C_DAK : s == 2 ? R_V : s == 3 ? C_DAZ : s == 4 ? C_SBQ : s == 5 ? C_SBK : s == 6 ? R_V + 1024 : s == 7 ? C_SBZ : s == 8 ? C_POOLU : s == 9 ? C_POOLZ : s == 10 ? C_MEMQ : C_MEMZ;
    return base + r;
}
__device__ __forceinline__ void convert_weights(const Params& p, LAS unsigned char* lds, int gw, int NGW, int wave, int lane) {
    LAS float* scr = (LAS float*)(lds + wave * 16384);
    constexpr int I_IN = 32 * 640, I_KV = 32 * 64, I_BR = 4 * 16 * 64, I_OUT = 32 * 64, I_POOL = 4 * 4 * 8, I_LAYER = I_IN + I_KV + I_BR + I_OUT + I_POOL;
    for (int it = gw; it < DEPTH * I_LAYER; it += NGW) {
        const int l = it / I_LAYER; int r = it % I_LAYER;
        bf16_t* wt = (bf16_t*)(p.ws + WS_WT + (size_t)l * WT_LAYER);
        if (r < I_IN) { const int kb = r / 640, nb = r % 640, n0 = nb * 32; transpose_item(p.w_in + (size_t)l * DM * INC, DM, INC, wt, (long)win_dest_row(n0) - n0, scr, kb, nb, lane); continue; } r -= I_IN;
        if (r < I_KV) { const int kb = r / 64, nb = r % 64, n0 = nb * 32; transpose_item(p.w_mem_kv + (size_t)l * DM * 2048, DM, 2048, wt, n0 < 1024 ? R_MK : R_MV - 1024, scr, kb, nb, lane); continue; } r -= I_KV;
        if (r < I_BR) { const int n = r / 1024, q = r % 1024, kb = q / 64, nb = q % 64; transpose_item(p.w_branch + ((size_t)l * 4 + n) * BW * DM, BW, DM, (bf16_t*)(p.ws + WS_WT + (size_t)l * WT_LAYER + WT_BR) + (size_t)n * DM * BW, 0, scr, kb, nb, lane); continue; } r -= I_BR;
        if (r < I_OUT) { const int kb = r / 64, nb = r % 64; transpose_item(p.w_out + (size_t)l * DM * DM, DM, DM, (bf16_t*)(p.ws + WS_WT + (size_t)l * WT_LAYER + WT_OUT), 0, scr, kb, nb, lane); continue; } r -= I_OUT;
        { const int g = r / 32, q = r % 32, kb = q / 8, nb = q % 8; transpose_item(p.w_pool + ((size_t)l * 4 + g) * 256 * 256, 256, 256, (bf16_t*)(p.ws + WS_WT + (size_t)l * WT_LAYER + WT_POOL) + (size_t)g * 256 * 256, 0, scr, kb, nb, lane); }
    }
}
__device__ __forceinline__ void rms_row_bf16(const float* xrow, const float* g, bf16_t* orow, int lane) {
    const f32x4* xr = (const f32x4*)xrow + lane; const f32x4* gr = (const f32x4*)g + lane;
    f32x4 v[8]; float s = 0.f;
#pragma unroll
    for (int j = 0; j < 8; ++j) { v[j] = xr[64 * j]; s += (v[j].x * v[j].x + v[j].y * v[j].y) + (v[j].z * v[j].z + v[j].w * v[j].w); }
    const float rstd = 1.f / sqrtf(wave_sum(s, lane) * (1.f / DM) + EPS);
    u32x2* o8 = (u32x2*)orow + lane;
#pragma unroll
    for (int j = 0; j < 8; ++j) { const f32x4 gg = gr[64 * j]; u32x2 w; w.x = cvt_pk_bf16(v[j].x * rstd * gg.x, v[j].y * rstd * gg.y); w.y = cvt_pk_bf16(v[j].z * rstd * gg.z, v[j].w * rstd * gg.w); o8[64 * j] = w; }
}
__device__ __forceinline__ void rms_rows2_bf16(const float* x0, const float* x1, const float* g, bf16_t* o0, bf16_t* o1, int lane) {
    const f32x4* xa = (const f32x4*)x0 + lane; const f32x4* xb = (const f32x4*)x1 + lane; const f32x4* gr = (const f32x4*)g + lane;
    f32x4 va[8], vb[8], gg[8]; float sa = 0.f, sb = 0.f;
#pragma unroll
    for (int j = 0; j < 8; ++j) { va[j] = xa[64 * j]; vb[j] = xb[64 * j]; gg[j] = gr[64 * j]; }
#pragma unroll
    for (int j = 0; j < 8; ++j) { sa += (va[j].x * va[j].x + va[j].y * va[j].y) + (va[j].z * va[j].z + va[j].w * va[j].w); sb += (vb[j].x * vb[j].x + vb[j].y * vb[j].y) + (vb[j].z * vb[j].z + vb[j].w * vb[j].w); }
    const float ra = 1.f / sqrtf(wave_sum(sa, lane) * (1.f / DM) + EPS), rb = 1.f / sqrtf(wave_sum(sb, lane) * (1.f / DM) + EPS);
    u32x2* pa = (u32x2*)o0 + lane; u32x2* pb = (u32x2*)o1 + lane;
#pragma unroll
    for (int j = 0; j < 8; ++j) { u32x2 w; w.x = cvt_pk_bf16(va[j].x * ra * gg[j].x, va[j].y * ra * gg[j].y); w.y = cvt_pk_bf16(va[j].z * ra * gg[j].z, va[j].w * ra * gg[j].w); pa[64 * j] = w;
        w.x = cvt_pk_bf16(vb[j].x * rb * gg[j].x, vb[j].y * rb * gg[j].y); w.y = cvt_pk_bf16(vb[j].z * rb * gg[j].z, vb[j].w * rb * gg[j].w); pb[64 * j] = w; }
}
__device__ __forceinline__ void norm_phase(const Params& p, int l, const float* xsrc, int gw, int NGW, int lane) {
    bf16_t* H = (bf16_t*)(p.ws + WS_H); bf16_t* MN = (bf16_t*)(p.ws + WS_MEMN);
    int m = gw;
    for (; m + NGW < NTOK; m += 2 * NGW) rms_rows2_bf16(xsrc + (size_t)m * DM, xsrc + (size_t)(m + NGW) * DM, p.norm_g + l * DM, H + (size_t)m * DM, H + (size_t)(m + NGW) * DM, lane);
    if (m < NTOK) rms_row_bf16(xsrc + (size_t)m * DM, p.norm_g + l * DM, H + (size_t)m * DM, lane);
    if (l == 0)
        for (int mm = gw; mm < 2 * NMEMTOK; mm += NGW) { const int l2 = mm >> 10, r = mm & 1023; rms_row_bf16(p.mem + (size_t)r * DM, p.mem_norm_g + l2 * DM, MN + (size_t)mm * DM, lane); }
}
__device__ __forceinline__ void final_norm_phase(const Params& p, int gw, int NGW, int lane) {
    const f32x4* gr = (const f32x4*)p.final_g + lane;
    int m = gw;
    for (; m + NGW < NTOK; m += 2 * NGW) {
        f32x4* xa = (f32x4*)(p.out + (size_t)m * DM) + lane; f32x4* xb = (f32x4*)(p.out + (size_t)(m + NGW) * DM) + lane;
        f32x4 va[8], vb[8], gg[8]; float sa = 0.f, sb = 0.f;
#pragma unroll
        for (int j = 0; j < 8; ++j) { va[j] = xa[64 * j]; vb[j] = xb[64 * j]; gg[j] = gr[64 * j]; }
#pragma unroll
        for (int j = 0; j < 8; ++j) { sa += (va[j].x * va[j].x + va[j].y * va[j].y) + (va[j].z * va[j].z + va[j].w * va[j].w); sb += (vb[j].x * vb[j].x + vb[j].y * vb[j].y) + (vb[j].z * vb[j].z + vb[j].w * vb[j].w); }
        const float ra = 1.f / sqrtf(wave_sum(sa, lane) * (1.f / DM) + EPS), rb = 1.f / sqrtf(wave_sum(sb, lane) * (1.f / DM) + EPS);
#pragma unroll
        for (int j = 0; j < 8; ++j) { xa[64 * j] = va[j] * ra * gg[j]; xb[64 * j] = vb[j] * rb * gg[j]; }
    }
    if (m < NTOK) {
        f32x4* xr = (f32x4*)(p.out + (size_t)m * DM) + lane;
        f32x4 v[8]; float s = 0.f;
#pragma unroll
        for (int j = 0; j < 8; ++j) { v[j] = xr[64 * j]; s += (v[j].x * v[j].x + v[j].y * v[j].y) + (v[j].z * v[j].z + v[j].w * v[j].w); }
        const float rstd = 1.f / sqrtf(wave_sum(s, lane) * (1.f / DM) + EPS);
#pragma unroll
        for (int j = 0; j < 8; ++j) xr[64 * j] = v[j] * rstd * gr[64 * j];
    }
}
__device__ __forceinline__ void pooled_phase(const Params& p, int gtid, int NGT) {
    if (gtid < 0) return;
    const bf16_t* __restrict__ P = (const bf16_t*)(p.ws + WS_P); bf16_t* __restrict__ PO = (bf16_t*)(p.ws + WS_POOLED);
#pragma unroll 2
    for (int it = gtid; it < NTOK * 128; it += NGT) {
        const int tok = it >> 7, ch = (it & 127) * 8, g = ch >> 8, w = 2 << g, s = tok & (SEQ - 1), cnt = (s + 1) < w ? (s + 1) : w;
        float a[8];
#pragma unroll
        for (int i = 0; i < 8; ++i) a[i] = 0.f;
        u32x4 uu[16];
#pragma unroll
        for (int j = 0; j < 16; ++j) { uu[j] = (u32x4){0u, 0u, 0u, 0u}; if (j < cnt) uu[j] = *(const u32x4*)(P + (size_t)(tok - j) * LDP + C_POOLU + ch); }
        const u32x4 u0 = uu[0];
#pragma unroll
        for (int j = 0; j < 16; ++j) { const u32x4 u = uu[j];
            a[0] += bflo(u.x); a[1] += bfhi(u.x); a[2] += bflo(u.y); a[3] += bfhi(u.y); a[4] += bflo(u.z); a[5] += bfhi(u.z); a[6] += bflo(u.w); a[7] += bfhi(u.w); }
        const float ic = 1.f / (float)cnt;
        u32x4 o; o.x = cvt_pk_bf16(a[0] * ic - bflo(u0.x), a[1] * ic - bfhi(u0.x)); o.y = cvt_pk_bf16(a[2] * ic - bflo(u0.y), a[3] * ic - bfhi(u0.y));
        o.z = cvt_pk_bf16(a[4] * ic - bflo(u0.z), a[5] * ic - bfhi(u0.z)); o.w = cvt_pk_bf16(a[6] * ic - bflo(u0.w), a[7] * ic - bfhi(u0.w));
        *(u32x4*)(PO + ((size_t)g * NTOK + tok) * 256 + (ch & 255)) = o;
    }
}
namespace att {
constexpr int VPITCH = 144, VBUF = 128 * VPITCH, O0_OFF = 2 * (64 * 144 + VBUF);
static_assert(2 * (64 * 528 + VBUF) <= RING_BYTES && O0_OFF + 65536 <= RING_BYTES, "attention LDS");
#define MFMA32(a, b, c) __builtin_amdgcn_mfma_f32_32x32x16_bf16((a), (b), (c), 0, 0, 0)
#define EX2(x) __builtin_amdgcn_exp2f(x)
#define LG2(x) __builtin_amdgcn_logf(x)

__device__ __forceinline__ float xhalf(float v) {
    const unsigned u = __float_as_uint(v); auto rr = __builtin_amdgcn_permlane32_swap(u, u, false, false); return __uint_as_float(rr[0] == u ? rr[1] : rr[0]); }
template <int DQK, int MODE, int NDT, int PF>
__device__ __forceinline__ void flash_pass(LAS unsigned char* lds, const bf16_t* Kg, int ldk, const bf16_t* Vg, int ldv, const bf16x8 (&qf)[DQK / 16], int NT, int qsw_min, float sc2,
                                           const LAS float* btab, f32x16 (&o)[NDT], float& m_run, float& l_run, int wv) {
    const int tid_ = wv * 64 + pg8::lane_id();
    const int tid = tid_, lane = tid & 63, r32 = lane & 31, hi = lane >> 5;
    constexpr int KP = DQK * 2 + 16, KPR = DQK / 8, KPT = DQK / 64, KBUF = 64 * KP, BUF = KBUF + VBUF, VPT = NDT / 2;
    const int qsw_max = qsw_min + 31, qs = qsw_min + r32;
    const int pm = (r32 & 0x13) | ((r32 & 4) << 1) | ((r32 & 8) >> 1);
    u32x4 kreg[PF][KPT], vreg[PF][VPT];
#define TILE(J) ((MODE == 1) ? NT - 1 - (J) : (J))
#define GLOAD(J, S) do { const int kt_ = TILE(J); _Pragma("unroll") for (int i_ = 0; i_ < KPT; ++i_) { const int p_ = tid + 512 * i_, row_ = p_ / KPR, cp_ = p_ % KPR; kreg[S][i_] = *(const u32x4*)(Kg + (size_t)(64 * kt_ + row_) * ldk + cp_ * 8); } \
    _Pragma("unroll") for (int i_ = 0; i_ < VPT; ++i_) { const int p_ = tid + 512 * i_, row_ = p_ >> 3, cp_ = p_ & 7; vreg[S][i_] = *(const u32x4*)(Vg + (size_t)row_ * ldv + 64 * kt_ + cp_ * 8); } } while (0)
#define LSTORE(B, S) do { _Pragma("unroll") for (int i_ = 0; i_ < KPT; ++i_) { const int p_ = tid + 512 * i_, row_ = p_ / KPR, cp_ = p_ % KPR; *(LAS u32x4*)(lds + (B) * BUF + row_ * KP + cp_ * 16) = kreg[S][i_]; } \
    _Pragma("unroll") for (int i_ = 0; i_ < VPT; ++i_) { const int p_ = tid + 512 * i_, row_ = p_ >> 3, cp_ = p_ & 7; *(LAS u32x4*)(lds + (B) * BUF + KBUF + row_ * VPITCH + cp_ * 16) = vreg[S][i_]; } } while (0)
#pragma unroll
    for (int j = 0; j < PF; ++j) if (j < NT) GLOAD(j, j);
    LSTORE(0, 0); if (PF < NT) GLOAD(PF, 0);
    __syncthreads();
    float R = 0.f; bool wave_done = false, all_done = false;
    float off_far = (MODE == 0) ? btab[128] - m_run : -m_run;
    LAS unsigned* dflag = (LAS unsigned*)(lds + MISC_OFF + 64);
    for (int it0 = 0; it0 < NT && !all_done; it0 += PF) {
#pragma unroll
    for (int u_ = 0; u_ < PF; ++u_) { const int it = it0 + u_;
      if (it < NT && !all_done) {
        const int kt = TILE(it);
        if (it + 1 < NT) { LSTORE((it + 1) & 1, (u_ + 1) % PF); if (it + 1 + PF < NT) GLOAD(it + 1 + PF, (u_ + 1) % PF); }
        const LAS unsigned char* kb = lds + (it & 1) * BUF; const LAS unsigned char* vb = kb + KBUF;
        const bool relevant = (MODE == 2) ? true : (MODE == 0 ? (64 * kt <= qsw_max) : ((64 * kt <= qsw_max - 1) && !wave_done));
        if (relevant) {
            f32x16 s[2];
#pragma unroll
            for (int st = 0; st < 2; ++st)
#pragma unroll
                for (int r = 0; r < 16; ++r) s[st][r] = 0.f;
            constexpr int DG = DQK / 64, NG = 2 * DG;
            constexpr bool PIPE = (MODE != 2); constexpr int NFB = PIPE ? 2 : 1;
            bf16x8 kf[NFB][4], vf[NFB][4];
#define KLOAD(g_, b_) do { _Pragma("unroll") for (int j_ = 0; j_ < 4; ++j_) kf[b_][j_] = *(const LAS bf16x8*)(kb + (32 * (j_ & 1) + pm) * KP + (16 * (2 * (g_) + (j_ >> 1)) + 8 * hi) * 2); } while (0)
#define VLOAD(dt_, b_) do { _Pragma("unroll") for (int j_ = 0; j_ < 4; ++j_) vf[b_][j_] = *(const LAS bf16x8*)(vb + (32 * (dt_) + r32) * VPITCH + (16 * j_ + 8 * hi) * 2); } while (0)
#define VLOADC(c_, b_) do { _Pragma("unroll") for (int j_ = 0; j_ < NDT; ++j_) vf[b_][j_] = *(const LAS bf16x8*)(vb + (32 * j_ + r32) * VPITCH + (16 * (c_) + 8 * hi) * 2); } while (0)
            if (PIPE) KLOAD(0, 0);
#pragma unroll
            for (int g = 0; g < NG; ++g) {
                __builtin_amdgcn_sched_barrier(0);
                if (PIPE) { if (g + 1 < NG) KLOAD(g + 1, (g + 1) & (NFB - 1)); else if (MODE == 1) VLOAD(0, 0); else VLOADC(0, 0); } else KLOAD(g, 0);
#pragma unroll
                for (int j = 0; j < 4; ++j) s[j & 1] = MFMA32(kf[g & (NFB - 1)][j], qf[2 * g + (j >> 1)], s[j & 1]);
            }
            __builtin_amdgcn_sched_barrier(0);
            int d0 = qs - 64 * kt - 8 * hi; asm volatile("" : "+v"(d0));
            if (MODE == 1) {
                const bool needmask = (64 * kt + 63 >= qsw_min);
#pragma unroll
                for (int st = 1; st >= 0; --st) {
                    float sp[16];
#pragma unroll
                    for (int r = 0; r < 16; ++r) { const float z2 = s[st][r] * sc2; s[st][r] = z2; float v = fmaxf(z2, 0.f) + LG2(1.f + EX2(-fabsf(z2)));
                        if (needmask) { if ((32 * st + 16 * (r >> 3) + (r & 7)) >= d0) v = 0.f; } sp[r] = v; }
                    const float sa = ((sp[0] + sp[1]) + (sp[2] + sp[3])) + ((sp[4] + sp[5]) + (sp[6] + sp[7])), sb = ((sp[8] + sp[9]) + (sp[10] + sp[11])) + ((sp[12] + sp[13]) + (sp[14] + sp[15]));
                    const float pa = xhalf(sa), pb = xhalf(sb);
                    float cB = R + (hi == 0 ? pb : 0.f), cA = R + sb + pb + (hi == 0 ? pa : 0.f);
#pragma unroll
                    for (int r = 15; r >= 8; --r) { cB += sp[r]; float a = EX2(s[st][r] - cB);
                        if (needmask) { if ((32 * st + 16 * (r >> 3) + (r & 7)) >= d0) a = 0.f; } s[st][r] = a; }
#pragma unroll
                    for (int r = 7; r >= 0; --r) { cA += sp[r]; float a = EX2(s[st][r] - cA);
                        if (needmask) { if ((32 * st + 16 * (r >> 3) + (r & 7)) >= d0) a = 0.f; } s[st][r] = a; }
                    R += (sa + sb) + (pa + pb);
                }
                wave_done = __all(R >= 160.f);
            } else {
                typedef float f32x2 __attribute__((ext_vector_type(2)));
                float mloc = -INFINITY;
                if (MODE == 0 && !(qsw_min - (64 * kt + 63) >= 128)) {
#pragma unroll
                    for (int st = 0; st < 2; ++st)
#pragma unroll
                        for (int r = 0; r < 16; ++r) { const int n = d0 - (32 * st + 16 * (r >> 3) + (r & 7)); const int nc = n < 0 ? 0 : (n > 128 ? 128 : n);
                            float v = s[st][r] * sc2 + (btab[nc] - m_run); if (n < 0) v = -INFINITY; s[st][r] = v; mloc = fmaxf(mloc, v); }
                } else {
                    const f32x2 scv = {sc2, sc2}, offv = {off_far, off_far};
#pragma unroll
                    for (int st = 0; st < 2; ++st)
#pragma unroll
                        for (int i = 0; i < 8; ++i) { f32x2 t = {s[st][2 * i], s[st][2 * i + 1]}; t = t * scv + offv; s[st][2 * i] = t.x; s[st][2 * i + 1] = t.y; mloc = fmaxf(mloc, fmaxf(t.x, t.y)); }
                }
                const bool first = (it == 0);
                float alpha = 1.f;
                if (first || __any(mloc > 8.f)) {
                    mloc = fmaxf(mloc, xhalf(mloc));
                    const float delta = first ? mloc : (mloc > 8.f ? mloc : 0.f);
                    alpha = first ? 1.f : EX2(-delta); m_run += delta; off_far -= delta;
                    const f32x2 dv = {delta, delta}, av = {alpha, alpha};
#pragma unroll
                    for (int dt = 0; dt < NDT; ++dt)
#pragma unroll
                        for (int i = 0; i < 8; ++i) { f32x2 t = {o[dt][2 * i], o[dt][2 * i + 1]}; t = t * av; o[dt][2 * i] = t.x; o[dt][2 * i + 1] = t.y; }
#pragma unroll
                    for (int st = 0; st < 2; ++st)
#pragma unroll
                        for (int i = 0; i < 8; ++i) { f32x2 t = {s[st][2 * i], s[st][2 * i + 1]}; t = t - dv; s[st][2 * i] = t.x; s[st][2 * i + 1] = t.y; }
                }
                f32x2 lsv = {0.f, 0.f};
                if (!PIPE) VLOADC(0, 0);
#pragma unroll
                for (int c4 = 0; c4 < 4; ++c4) { const int st = c4 >> 1, b8 = 8 * (c4 & 1);
                    float pe[8];
#pragma unroll
                    for (int i = 0; i < 8; ++i) pe[i] = EX2(s[st][b8 + i]);
#pragma unroll
                    for (int i = 0; i < 4; ++i) { const f32x2 t = {pe[2 * i], pe[2 * i + 1]}; lsv = lsv + t; }
                    u32x4 w; w.x = cvt_pk_bf16(pe[0], pe[1]); w.y = cvt_pk_bf16(pe[2], pe[3]); w.z = cvt_pk_bf16(pe[4], pe[5]); w.w = cvt_pk_bf16(pe[6], pe[7]);
                    const bf16x8 pkc = __builtin_bit_cast(bf16x8, w);
                    if (PIPE) { if (c4 + 1 < 4) VLOADC(c4 + 1, (c4 + 1) & (NFB - 1)); } else if (c4 > 0) VLOADC(c4, 0);
#pragma unroll
                    for (int dt = 0; dt < NDT; ++dt) o[dt] = MFMA32(vf[c4 & (NFB - 1)][dt], pkc, o[dt]);
                }
                const float ls = lsv.x + lsv.y;
                l_run = l_run * alpha + ls;
#if 0
                if (MODE == 0) {
                    __builtin_amdgcn_sched_group_barrier(0x002, 16, 0);
#pragma unroll
                    for (int c4 = 0; c4 < 3; ++c4)
#pragma unroll
                        for (int dt = 0; dt < NDT; ++dt) { __builtin_amdgcn_sched_group_barrier(0x008, 1, 0); __builtin_amdgcn_sched_group_barrier(0x100, 1, 0); __builtin_amdgcn_sched_group_barrier(0x002, 4, 0); }
                    __builtin_amdgcn_sched_group_barrier(0x008, NDT, 0);
                }
#endif
            }
            if (MODE == 1) {
            bf16x8 pk[4];
#pragma unroll
            for (int c4 = 0; c4 < 4; ++c4) { const int st = c4 >> 1, b8 = 8 * (c4 & 1); u32x4 w;
                w.x = cvt_pk_bf16(s[st][b8], s[st][b8 + 1]); w.y = cvt_pk_bf16(s[st][b8 + 2], s[st][b8 + 3]); w.z = cvt_pk_bf16(s[st][b8 + 4], s[st][b8 + 5]); w.w = cvt_pk_bf16(s[st][b8 + 6], s[st][b8 + 7]);
                pk[c4] = __builtin_bit_cast(bf16x8, w); }
#pragma unroll
            for (int dt = 0; dt < NDT; ++dt) {
                __builtin_amdgcn_sched_barrier(0);
                if (dt + 1 < NDT) VLOAD(dt + 1, (dt + 1) & 1);
#pragma unroll
                for (int c4 = 0; c4 < 4; ++c4) o[dt] = MFMA32(vf[dt & 1][c4], pk[c4], o[dt]);
            }
            }
            __builtin_amdgcn_sched_barrier(0);
#undef KLOAD
#undef VLOAD
#undef VLOADC
        }
        if (MODE == 1) { if (lane == 0) dflag[(it & 1) * 8 + (tid >> 6)] = wave_done ? 1u : 0u; }
#if PROBE_DUP == 23
        if (MODE == 0) __syncthreads();
#endif
        __syncthreads();
        if (MODE == 1) { const u32x4 f0 = *(const LAS u32x4*)(dflag + (it & 1) * 8), f1 = *(const LAS u32x4*)(dflag + (it & 1) * 8 + 4);
            if ((f0.x & f0.y & f0.z & f0.w & f1.x & f1.y & f1.z & f1.w) != 0u) all_done = true; }
      } }
    }
#undef GLOAD
#undef LSTORE
#undef TILE
}

__device__ __forceinline__ void zero_o(f32x16 (&o)[4]) {
#pragma unroll
    for (int dt = 0; dt < 4; ++dt)
#pragma unroll
        for (int r = 0; r < 16; ++r) o[dt][r] = 0.f;
}
__device__ __forceinline__ void diff_unit(const Params& p, LAS unsigned char* lds, int l, int b, int h, int qb, int wv) {
    const int tid_ = wv * 64 + pg8::lane_id();
    const int tid = tid_, lane = tid & 63, wid = tid >> 6, r32 = lane & 31, hi = lane >> 5;
    const bf16_t* P = (const bf16_t*)(p.ws + WS_P); const bf16_t* VT = (const bf16_t*)(p.ws + WS_VT); bf16_t* BR = (bf16_t*)(p.ws + WS_BR);
    const float* ctlf = (const float*)(p.ws + WS_CTL);
    LAS float* btab = (LAS float*)(lds + MISC_OFF + 256);
    if (tid < 129) btab[tid] = ctlf[CTL_BTAB + h * BT_STRIDE + tid];
    const float lam = ctlf[CTL_LAM + l];
    const int qsw_min = qb * 256 + wid * 32, tok = b * SEQ + qsw_min + r32, NT = 4 * (qb + 1);
    f32x16 o[4]; LAS unsigned* o0s = (LAS unsigned*)(lds + O0_OFF + wid * 8192) + lane;
    for (int c = 0; c < 2; ++c) {
        bf16x8 qf[4];
#pragma unroll
        for (int dc = 0; dc < 4; ++dc) qf[dc] = *(const bf16x8*)(P + (size_t)tok * LDP + C_DAQ + h * 128 + c * 64 + 16 * dc + 8 * hi);
        zero_o(o); float m_run = 0.f, l_run = 0.f;
        flash_pass<64, 0, 4, 3>(lds, P + (size_t)b * SEQ * LDP + C_DAK + h * 128 + c * 64, LDP, VT + (size_t)(h * 128) * NTOK + (size_t)b * SEQ, NTOK, qf, NT, qsw_min, 0.125f * LOG2E, btab, o, m_run, l_run, wv);
        const float lt = l_run + xhalf(l_run), inv = 1.f / lt;
        if (c == 0) {
#pragma unroll
            for (int dt = 0; dt < 4; ++dt)
#pragma unroll
                for (int r = 0; r < 8; ++r) o0s[(dt * 8 + r) * 64] = cvt_pk_bf16(o[dt][2 * r] * inv, o[dt][2 * r + 1] * inv);
        } else {
            const float li = lam * inv;
#pragma unroll
            for (int dt = 0; dt < 4; ++dt)
#pragma unroll
                for (int r = 0; r < 8; ++r) { const unsigned w0 = o0s[(dt * 8 + r) * 64]; o[dt][2 * r] = bflo(w0) - li * o[dt][2 * r]; o[dt][2 * r + 1] = bfhi(w0) - li * o[dt][2 * r + 1]; }
        }
    }
    const int lane_e = pg8::lane_id(), r32_e = lane_e & 31, hi_e = lane_e >> 5; const size_t tok_e = (size_t)(b * SEQ + qsw_min + r32_e);
    float ss = 0.f;
#pragma unroll
    for (int dt = 0; dt < 4; ++dt)
#pragma unroll
        for (int r = 0; r < 16; ++r) ss += o[dt][r] * o[dt][r];
    ss += xhalf(ss);
    const float rn = ctlf[CTL_LAM + 2 + l] / sqrtf(ss * (1.f / 128.f) + EPS);
    u32x2 zz[16]; f32x4 gg[16];
#pragma unroll
    for (int dt = 0; dt < 4; ++dt)
#pragma unroll
        for (int rg = 0; rg < 4; ++rg) { const int col = h * 128 + 32 * dt + 8 * rg + 4 * hi_e;
            zz[dt * 4 + rg] = *(const u32x2*)(P + tok_e * LDP + C_DAZ + col); gg[dt * 4 + rg] = *(const f32x4*)(p.da_norm_g + l * BW + col); }
#pragma unroll
    for (int dt = 0; dt < 4; ++dt)
#pragma unroll
        for (int rg = 0; rg < 4; ++rg) { const int col = h * 128 + 32 * dt + 8 * rg + 4 * hi_e;
            const u32x2 z = zz[dt * 4 + rg]; const f32x4 g = gg[dt * 4 + rg];
            u32x2 w; w.x = cvt_pk_bf16(o[dt][4 * rg] * rn * g[0] * silu_f(bflo(z.x)), o[dt][4 * rg + 1] * rn * g[1] * silu_f(bfhi(z.x)));
            w.y = cvt_pk_bf16(o[dt][4 * rg + 2] * rn * g[2] * silu_f(bflo(z.y)), o[dt][4 * rg + 3] * rn * g[3] * silu_f(bfhi(z.y)));
            *(u32x2*)(BR + tok_e * BW + col) = w; }
}
__device__ __forceinline__ void sb_unit(const Params& p, LAS unsigned char* lds, int b, int h, int qb, int wv) {
    const int tid_ = wv * 64 + pg8::lane_id();
    const int tid = tid_, lane = tid & 63, wid = tid >> 6, r32 = lane & 31, hi = lane >> 5;
    const bf16_t* P = (const bf16_t*)(p.ws + WS_P); const bf16_t* VT = (const bf16_t*)(p.ws + WS_VT); bf16_t* BR = (bf16_t*)(p.ws + WS_BR) + (size_t)1 * NTOK * BW;
    const int qsw_min = qb * 256 + wid * 32, tok = b * SEQ + qsw_min + r32, NT = 4 * (qb + 1);
    bf16x8 qf[8];
#pragma unroll
    for (int dc = 0; dc < 8; ++dc) qf[dc] = *(const bf16x8*)(P + (size_t)tok * LDP + C_SBQ + h * 128 + 16 * dc + 8 * hi);
    f32x16 o[4]; zero_o(o); float m_run = 0.f, l_run = 0.f;
    flash_pass<128, 1, 4, 1>(lds, P + (size_t)b * SEQ * LDP + C_SBK + h * 128, LDP, VT + (size_t)(1024 + h * 128) * NTOK + (size_t)b * SEQ, NTOK, qf, NT, qsw_min, 0.08838834764831845f * LOG2E, nullptr, o, m_run, l_run, wv);
    const int lane_e = pg8::lane_id(), r32_e = lane_e & 31, hi_e = lane_e >> 5; const size_t tok_e = (size_t)(b * SEQ + qsw_min + r32_e);
    u32x2 zz[16];
#pragma unroll
    for (int dt = 0; dt < 4; ++dt)
#pragma unroll
        for (int rg = 0; rg < 4; ++rg) zz[dt * 4 + rg] = *(const u32x2*)(P + tok_e * LDP + C_SBZ + h * 128 + 32 * dt + 8 * rg + 4 * hi_e);
#pragma unroll
    for (int dt = 0; dt < 4; ++dt)
#pragma unroll
        for (int rg = 0; rg < 4; ++rg) { const int col = h * 128 + 32 * dt + 8 * rg + 4 * hi_e;
            const u32x2 z = zz[dt * 4 + rg];
            u32x2 w; w.x = cvt_pk_bf16(o[dt][4 * rg] * silu_f(bflo(z.x)), o[dt][4 * rg + 1] * silu_f(bfhi(z.x)));
            w.y = cvt_pk_bf16(o[dt][4 * rg + 2] * silu_f(bflo(z.y)), o[dt][4 * rg + 3] * silu_f(bfhi(z.y)));
            *(u32x2*)(BR + tok_e * BW + col) = w; }
}
__device__ __forceinline__ void mem_unit(const Params& p, LAS unsigned char* lds, int l, int b, int hm, int qb, int quarter, int wv) {
    const int tid_ = wv * 64 + pg8::lane_id();
    const int tid = tid_, lane = tid & 63, wid = tid >> 6, r32 = lane & 31, hi = lane >> 5;
    const bf16_t* P = (const bf16_t*)(p.ws + WS_P); const bf16_t* MK = (const bf16_t*)(p.ws + WS_MKV + (size_t)(2 * l) * 2 * MiB); const bf16_t* MVT = (const bf16_t*)(p.ws + WS_MKV + (size_t)(2 * l + 1) * 2 * MiB); bf16_t* BR = (bf16_t*)(p.ws + WS_BR) + (size_t)3 * NTOK * BW;
    const int qsw_min = qb * 256 + wid * 32, tok = b * SEQ + qsw_min + r32;
    bf16x8 qf[16];
#pragma unroll
    for (int dc = 0; dc < 16; ++dc) qf[dc] = *(const bf16x8*)(P + (size_t)tok * LDP + C_MEMQ + hm * 256 + 16 * dc + 8 * hi);
    f32x16 o[2];
#pragma unroll
    for (int dt = 0; dt < 2; ++dt)
#pragma unroll
        for (int r = 0; r < 16; ++r) o[dt][r] = 0.f;
    float m_run = 0.f, l_run = 0.f;
    flash_pass<256, 2, 2, 1>(lds, MK + (size_t)(b * NMEM) * BW + hm * 256, BW, MVT + (size_t)(hm * 256 + quarter * 64) * NMEMTOK + b * NMEM, NMEMTOK, qf, 4, qsw_min, 0.0625f * LOG2E, nullptr, o, m_run, l_run, wv);
    const int lane_e = pg8::lane_id(), r32_e = lane_e & 31, hi_e = lane_e >> 5; const size_t tok_e = (size_t)(b * SEQ + qsw_min + r32_e);
    const float lt = l_run + xhalf(l_run), inv = 1.f / lt;
#pragma unroll
    for (int dt = 0; dt < 2; ++dt)
#pragma unroll
        for (int rg = 0; rg < 4; ++rg) { const int col = hm * 256 + quarter * 64 + 32 * dt + 8 * rg + 4 * hi_e;
            const u32x2 z = *(const u32x2*)(P + tok_e * LDP + C_MEMZ + col);
            u32x2 w; w.x = cvt_pk_bf16(o[dt][4 * rg] * inv * silu_f(bflo(z.x)), o[dt][4 * rg + 1] * inv * silu_f(bfhi(z.x)));
            w.y = cvt_pk_bf16(o[dt][4 * rg + 2] * inv * silu_f(bflo(z.y)), o[dt][4 * rg + 3] * inv * silu_f(bfhi(z.y)));
            *(u32x2*)(BR + tok_e * BW + col) = w; }
}
__device__ __forceinline__ void mem_unit2(const Params& p, LAS unsigned char* lds, int l, int b, int hm, int qb, int wv) {
    const bf16_t* P = (const bf16_t*)(p.ws + WS_P); const bf16_t* MK = (const bf16_t*)(p.ws + WS_MKV + (size_t)(2 * l) * 2 * MiB); const bf16_t* MVT = (const bf16_t*)(p.ws + WS_MKV + (size_t)(2 * l + 1) * 2 * MiB); bf16_t* BR = (bf16_t*)(p.ws + WS_BR) + (size_t)3 * NTOK * BW;
    const int lane = pg8::lane_id(), tid = wv * 64 + lane, r32 = lane & 31, hi = lane >> 5;
    const int qsw_min = qb * 256 + wv * 32; const size_t tok = (size_t)(b * SEQ + qsw_min + r32);
    const int pm = (r32 & 0x13) | ((r32 & 4) << 1) | ((r32 & 8) >> 1);
    constexpr int KP2 = 272, BUF2 = 18432;
    u32x4 sreg[2];
    f32x16 S[8];
#pragma unroll
    for (int i = 0; i < 8; ++i)
#pragma unroll
        for (int r = 0; r < 16; ++r) S[i][r] = 0.f;
#define GLK(IT) do { const int dh_ = (IT) >> 2, kt_ = (IT) & 3; _Pragma("unroll") for (int i_ = 0; i_ < 2; ++i_) { const int p_ = tid + 512 * i_, row_ = p_ >> 4, cp_ = p_ & 15; \
        sreg[i_] = *(const u32x4*)(MK + (size_t)(b * NMEM + 64 * kt_ + row_) * BW + hm * 256 + dh_ * 128 + cp_ * 8); } } while (0)
#define LSK(B) do { _Pragma("unroll") for (int i_ = 0; i_ < 2; ++i_) { const int p_ = tid + 512 * i_, row_ = p_ >> 4, cp_ = p_ & 15; *(LAS u32x4*)(lds + (B) * BUF2 + row_ * KP2 + cp_ * 16) = sreg[i_]; } } while (0)
    GLK(0); LSK(0); __syncthreads();
    bf16x8 qh[8];
#pragma unroll
    for (int it = 0; it < 8; ++it) {
        if (it + 1 < 8) GLK(it + 1);
        if ((it & 3) == 0) {
#pragma unroll
            for (int dc = 0; dc < 8; ++dc) qh[dc] = *(const bf16x8*)(P + tok * LDP + C_MEMQ + hm * 256 + (it >> 2) * 128 + 16 * dc + 8 * hi); }
        const LAS unsigned char* kb = lds + (it & 1) * BUF2;
        bf16x8 kf[2][4];
#pragma unroll
        for (int j = 0; j < 4; ++j) kf[0][j] = *(const LAS bf16x8*)(kb + (32 * (j & 1) + pm) * KP2 + (16 * (j >> 1) + 8 * hi) * 2);
#pragma unroll
        for (int g = 0; g < 4; ++g) {
            __builtin_amdgcn_sched_barrier(0);
            if (g + 1 < 4) {
#pragma unroll
                for (int j = 0; j < 4; ++j) kf[(g + 1) & 1][j] = *(const LAS bf16x8*)(kb + (32 * (j & 1) + pm) * KP2 + (16 * (2 * (g + 1) + (j >> 1)) + 8 * hi) * 2); }
#pragma unroll
            for (int j = 0; j < 4; ++j) S[2 * (it & 3) + (j & 1)] = MFMA32(kf[g & 1][j], qh[2 * g + (j >> 1)], S[2 * (it & 3) + (j & 1)]);
        }
        __builtin_amdgcn_sched_barrier(0);
        if (it + 1 < 8) LSK((it + 1) & 1);
        __syncthreads();
    }
#undef GLK
#undef LSK
    const float sc2 = 0.0625f * LOG2E;
    float mx = -INFINITY;
#pragma unroll
    for (int i = 0; i < 8; ++i)
#pragma unroll
        for (int r = 0; r < 16; ++r) mx = fmaxf(mx, S[i][r]);
    mx = fmaxf(mx, xhalf(mx));
    const float moff = -mx * sc2;
    float ls = 0.f; bf16x8 pk16[16];
#pragma unroll
    for (int c = 0; c < 16; ++c) { float pe[8];
#pragma unroll
        for (int i = 0; i < 8; ++i) { pe[i] = EX2(S[c >> 1][8 * (c & 1) + i] * sc2 + moff); ls += pe[i]; }
        u32x4 w; w.x = cvt_pk_bf16(pe[0], pe[1]); w.y = cvt_pk_bf16(pe[2], pe[3]); w.z = cvt_pk_bf16(pe[4], pe[5]); w.w = cvt_pk_bf16(pe[6], pe[7]); pk16[c] = __builtin_bit_cast(bf16x8, w); }
    const float inv = 1.f / (ls + xhalf(ls));
#define GLV(IT) do { const int dvh_ = (IT) >> 2, kt_ = (IT) & 3; _Pragma("unroll") for (int i_ = 0; i_ < 2; ++i_) { const int p_ = tid + 512 * i_, row_ = p_ >> 3, cp_ = p_ & 7; \
        sreg[i_] = *(const u32x4*)(MVT + (size_t)(hm * 256 + dvh_ * 128 + row_) * NMEMTOK + b * NMEM + 64 * kt_ + cp_ * 8); } } while (0)
#define LSV(B) do { _Pragma("unroll") for (int i_ = 0; i_ < 2; ++i_) { const int p_ = tid + 512 * i_, row_ = p_ >> 3, cp_ = p_ & 7; *(LAS u32x4*)(lds + (B) * BUF2 + row_ * VPITCH + cp_ * 16) = sreg[i_]; } } while (0)
    GLV(0); LSV(0); __syncthreads();
    f32x16 o[4];
#pragma unroll
    for (int it = 0; it < 8; ++it) {
        if (it + 1 < 8) GLV(it + 1);
        if ((it & 3) == 0) zero_o(o);
        const LAS unsigned char* vb = lds + (it & 1) * BUF2;
        bf16x8 vf[2][4];
#pragma unroll
        for (int j = 0; j < 4; ++j) vf[0][j] = *(const LAS bf16x8*)(vb + (32 * j + r32) * VPITCH + (8 * hi) * 2);
#pragma unroll
        for (int c4 = 0; c4 < 4; ++c4) {
            __builtin_amdgcn_sched_barrier(0);
            if (c4 + 1 < 4) {
#pragma unroll
                for (int j = 0; j < 4; ++j) vf[(c4 + 1) & 1][j] = *(const LAS bf16x8*)(vb + (32 * j + r32) * VPITCH + (16 * (c4 + 1) + 8 * hi) * 2); }
#pragma unroll
            for (int j = 0; j < 4; ++j) o[j] = MFMA32(vf[c4 & 1][j], pk16[4 * (it & 3) + c4], o[j]);
        }
        __builtin_amdgcn_sched_barrier(0);
        if (it + 1 < 8) LSV((it + 1) & 1);
        if ((it & 3) == 3) {
            u32x2 zz[16];
#pragma unroll
            for (int dt = 0; dt < 4; ++dt)
#pragma unroll
                for (int rg = 0; rg < 4; ++rg) zz[dt * 4 + rg] = *(const u32x2*)(P + tok * LDP + C_MEMZ + hm * 256 + (it >> 2) * 128 + 32 * dt + 8 * rg + 4 * hi);
#pragma unroll
            for (int dt = 0; dt < 4; ++dt)
#pragma unroll
                for (int rg = 0; rg < 4; ++rg) { const int col = hm * 256 + (it >> 2) * 128 + 32 * dt + 8 * rg + 4 * hi;
                    const u32x2 z = zz[dt * 4 + rg];
                    u32x2 w; w.x = cvt_pk_bf16(o[dt][4 * rg] * inv * silu_f(bflo(z.x)), o[dt][4 * rg + 1] * inv * silu_f(bfhi(z.x)));
                    w.y = cvt_pk_bf16(o[dt][4 * rg + 2] * inv * silu_f(bflo(z.y)), o[dt][4 * rg + 3] * inv * silu_f(bfhi(z.y)));
                    *(u32x2*)(BR + tok * BW + col) = w; } }
        __syncthreads();
    }
#undef GLV
#undef LSV
}
__device__ __forceinline__ void mixer_phase(const Params& p, LAS unsigned char* lds, int l, int ci, int kmask, int wv) {
    unsigned* ctr = (unsigned*)(p.ws + WS_CTL) + CTL_Q + 64 * ci;
    LAS unsigned* qw = (LAS unsigned*)(lds + MISC_OFF);
    for (unsigned k = 0;; ++k) {
        if (wv == 0 && pg8::lane_id() == 0) qw[k & 1] = atomicAdd(ctr, 1u);
        __syncthreads(); const unsigned u = qw[k & 1];
        if (u >= 1280u) break;
        if (u < 1024u) { const int qb = 15 - (int)(u >> 6), r = (int)(u & 63), kind = r >> 5, bh = r & 31;
#ifndef NO_SB
            if (kind == 0 && (kmask & 1)) sb_unit(p, lds, bh >> 3, bh & 7, qb, wv);
#endif
#ifndef NO_DIFF
            if (kind == 1 && (kmask & 2)) diff_unit(p, lds, l, bh >> 3, bh & 7, qb, wv);
#endif
        } else { const int v = (int)u - 1024, qb = v & 15, bhm = v >> 4;
#ifndef NO_MEM
            if (kmask & 4) mem_unit2(p, lds, l, bhm >> 2, bhm & 3, qb, wv);
#endif
        }
    }
}
}

__global__ void __launch_bounds__(NTHR, 2) fwd_megakernel(Params p_arg) {
    extern __shared__ __attribute__((aligned(16))) unsigned char lds_raw[];
    LAS unsigned char* lds = (LAS unsigned char*)lds_raw;
    cg::grid_group grid = cg::this_grid();
    const int G = gridDim.x, bx = blockIdx.x, wave_s = __builtin_amdgcn_readfirstlane(threadIdx.x >> 6);
    (void)p_arg;
    if (threadIdx.x < 4) ((LAS unsigned*)(lds + MISC_OFF + 128))[threadIdx.x] = 0u;
    __syncthreads();
    (void)xcd_barrier_post((unsigned*)(kparams()->ws + WS_CTL) + CTL_BAR, (volatile LAS unsigned*)(lds + MISC_OFF + 128));
#define GRID_BAR() do { XcdBarrier xb_; xb_.bar = (unsigned*)(kparams()->ws + WS_CTL) + CTL_BAR; xb_.x = xb_xcc_id(); xb_.wv = wave_s; xb_.st = (volatile LAS unsigned*)(lds + MISC_OFF + 128); xcd_barrier(xb_); } while (0)
#define p (*kparams())
#define TIDS() const int wave = wave_s, lane = pg8::lane_id(), tid = wave * 64 + lane, gw = bx * NWAVES + wave, NGW = G * NWAVES; (void)lane; (void)gw; (void)NGW;
    if (bx == 0) { TIDS();
        float* ctlf = (float*)(p.ws + WS_CTL); unsigned* ctlu = (unsigned*)(p.ws + WS_CTL);
        for (int i = tid; i < 8 * 129; i += NTHR) { const int h = i / 129, n = i % 129; int bucket;
            if (n < 16) bucket = n; else { const float t = logf((float)n / 16.f) / logf(8.f) * 16.f; int lg = 16 + (int)t; bucket = lg > 31 ? 31 : lg; }
            if (n >= 128) bucket = 31;
            ctlf[CTL_BTAB + h * BT_STRIDE + n] = p.rel_bias[bucket * 8 + h] * LOG2E; }
        if (tid >= 64 && tid < 66) { const int l = tid - 64; float s1 = 0.f, s2 = 0.f;
            for (int i = 0; i < 64; ++i) { s1 += p.lq1[l * 64 + i] * p.lk1[l * 64 + i]; s2 += p.lq2[l * 64 + i] * p.lk2[l * 64 + i]; }
            const float lam_init = 0.8f - 0.6f * expf(-0.3f * (float)l); ctlf[CTL_LAM + l] = expf(s1) - expf(s2) + lam_init; ctlf[CTL_LAM + 2 + l] = 1.f - lam_init; }
    }
    { TIDS(); convert_weights(p, lds, gw, NGW, wave, lane);
#if PROBE_DUP == 3
      convert_weights(p, lds, gw, NGW, wave, lane);
#endif
      norm_phase(p, 0, p.x, gw, NGW, lane); }
    grid.sync();
    for (int l = 0; l < DEPTH; ++l) {
        const bf16_t* WT = (const bf16_t*)(p.ws + WS_WT + (size_t)l * WT_LAYER);
        bf16_t* H = (bf16_t*)(p.ws + WS_H); bf16_t* PB = (bf16_t*)(p.ws + WS_P);
#if PROBE_DUP == 2
        for (int rep_ = 0; rep_ < 2; ++rep_)
#endif
        { pg8::Gemm g{(const bf16_t*)p.ws, (const bf16_t*)p.ws, wave_s, 0, DM}; pg8::SchedP1 S{(int)(WS_H / MiB), (int)((WS_WT + (size_t)l * WT_LAYER) / MiB), G, bx};
          pg8::EpiP1 E{p.ws, p.gate_b + (size_t)l * 4 * DM, wave_s};
          pg8::gemm_phase<pg8::EpiP1, pg8::SchedP1, true, true>(lds, g, S, E); }
        GRID_BAR();
        { const bool memg = (l == 0) && (bx < 64) && (G > 64);
          if (memg) { pg8::Gemm g{(const bf16_t*)p.ws, (const bf16_t*)p.ws, wave_s, 0, DM}; pg8::SchedMem S{(int)(WS_MEMN / MiB), (int)(WS_WT / MiB), (int)(WT_LAYER / MiB), G, bx};
              pg8::EpiP1 E{p.ws, p.gate_b, wave_s};
              pg8::gemm_phase<pg8::EpiP1, pg8::SchedMem, true, true>(lds, g, S, E); }
          else { TIDS(); const int sk = (l == 0 && G > 64) ? 64 : 0; pooled_phase(p, (bx - sk) * NTHR + tid, (G - sk) * NTHR); } }
        GRID_BAR();
#ifndef NO_ATT
        att::mixer_phase(p, lds, l, l, 7, wave_s);
#if PROBE_DUP >= 11 && PROBE_DUP <= 17
        att::mixer_phase(p, lds, l, l + 2, PROBE_DUP - 10, wave_s);
#endif
#endif
#ifndef NO_G3
        { pg8::Gemm g{(const bf16_t*)(p.ws + WS_POOLED), (const bf16_t*)(p.ws + WS_WT + (size_t)l * WT_LAYER + WT_POOL), wave_s, 0, 256}; pg8::SchedPool S{G, bx};
          pg8::EpiPool E{PB, p.pool_scale + l * BW, (bf16_t*)(p.ws + WS_BR) + (size_t)2 * NTOK * BW, wave_s};
          pg8::gemm_phase<pg8::EpiPool, pg8::SchedPool, true, true>(lds, g, S, E); }
#endif

        GRID_BAR();
#if PROBE_DUP == 4
        for (int rep_ = 0; rep_ < 2; ++rep_)
#endif
#ifndef NO_G4
        { pg8::Gemm g{(const bf16_t*)(p.ws + WS_BR), (const bf16_t*)(p.ws + WS_WT + (size_t)l * WT_LAYER + WT_BR), wave_s, 0, BW}; pg8::SchedBranch S{G, bx};
          pg8::EpiMergeChain E{PB, H, wave_s};
          pg8::gemm_phase<pg8::EpiMergeChain, pg8::SchedBranch, true, true>(lds, g, S, E); }
#endif
        GRID_BAR();
#ifndef NO_G5
        { pg8::Gemm g{H, (const bf16_t*)(p.ws + WS_WT + (size_t)l * WT_LAYER + WT_OUT), wave_s, 0, DM}; pg8::Sched2 S{64, 8, G, bx};
          pg8::EpiOut E{l == 0 ? p.x : p.out, p.out, wave_s};
          pg8::gemm_phase<pg8::EpiOut, pg8::Sched2, true, true>(lds, g, S, E); }
#endif

        GRID_BAR();
        if (l + 1 < DEPTH) { { TIDS(); norm_phase(p, l + 1, p.out, gw, NGW, lane); } GRID_BAR(); }
    }
#if PROBE_DUP == 5
    for (int rep_ = 0; rep_ < 20; ++rep_) GRID_BAR();
#endif
    { TIDS(); final_norm_phase(p, gw, NGW, lane); }
#undef p
}

extern "C" void kernel_launch(void* const* d_in, const int* in_sizes, int n_in, void* d_out, int out_size, void* d_ws, size_t ws_size, hipStream_t stream) {
    static int grid = 0;
    if (grid == 0) {
        if (n_in != 18 || out_size != NTOK * DM || ws_size < WS_END) { fprintf(stderr, "kernel_launch: unexpected shapes (n_in %d out %d ws %zu)\n", n_in, out_size, ws_size); grid = -1; return; }
        int dev = 0, cus = 0, per_cu = 0;
        hipGetDevice(&dev); hipDeviceGetAttribute(&cus, hipDeviceAttributeMultiprocessorCount, dev);
        if (hipFuncSetAttribute((const void*)fwd_megakernel, hipFuncAttributeMaxDynamicSharedMemorySize, LDS_BYTES) != hipSuccess) fprintf(stderr, "kernel_launch: hipFuncSetAttribute failed\n");
        if (hipOccupancyMaxActiveBlocksPerMultiprocessor(&per_cu, (const void*)fwd_megakernel, NTHR, LDS_BYTES) != hipSuccess || per_cu < 1) { fprintf(stderr, "kernel_launch: occupancy query gave %d\n", per_cu); per_cu = 1; }
        (void)hipGetLastError();
        grid = cus * per_cu;
    }
    if (grid < 0) return;
    Params p{};
    p.x = (const float*)d_in[0]; p.mem = (const float*)d_in[1]; p.rel_bias = (const float*)d_in[2]; p.norm_g = (const float*)d_in[3]; p.w_in = (const float*)d_in[4]; p.gate_b = (const float*)d_in[5];
    p.lq1 = (const float*)d_in[6]; p.lk1 = (const float*)d_in[7]; p.lq2 = (const float*)d_in[8]; p.lk2 = (const float*)d_in[9]; p.da_norm_g = (const float*)d_in[10]; p.w_pool = (const float*)d_in[11];
    p.pool_scale = (const float*)d_in[12]; p.mem_norm_g = (const float*)d_in[13]; p.w_mem_kv = (const float*)d_in[14]; p.w_branch = (const float*)d_in[15]; p.w_out = (const float*)d_in[16]; p.final_g = (const float*)d_in[17];
    p.out = (float*)d_out; p.ws = (unsigned char*)d_ws;
    if (hipMemsetAsync(d_ws, 0, CTL_ZERO_BYTES, stream) != hipSuccess) { fprintf(stderr, "kernel_launch: memset failed\n"); return; }
    void* args[] = {&p};
    hipError_t e = hipLaunchCooperativeKernel((const void*)fwd_megakernel, dim3(grid), dim3(NTHR), args, LDS_BYTES, stream);
    if (e != hipSuccess) fprintf(stderr, "kernel_launch: cooperative launch failed: %s (grid %d)\n", hipGetErrorString(e), grid);
}
```

```cpp
#define PROBE_DUP 0
#include <hip/hip_runtime.h>
#include <hip/hip_cooperative_groups.h>
#include <cstdio>
#include <cstdint>
namespace cg = cooperative_groups;

namespace pg8 {
#define PG8_LAS __attribute__((address_space(3)))
typedef unsigned short bf16_t;
typedef short bf16x8 __attribute__((ext_vector_type(8)));
typedef float f32x4 __attribute__((ext_vector_type(4)));
typedef unsigned u32x4 __attribute__((ext_vector_type(4)));
typedef unsigned u32x2 __attribute__((ext_vector_type(2)));
constexpr int BM = 256, BK = 64, HALF = 128, HTB = HALF * BK * 2  , STAGE_BYTES = 8 * HTB, NXCD = 8, WGM = 8;

__host__ __device__ __forceinline__ int lds_byte(int r, int c) { const int st = (r >> 4) * 2 + (c >> 5), rr = r & 15, cc = c & 31, ob = rr * 64 + cc * 2; return st * 1024 + (ob ^ (((ob >> 9) & 1) << 5)); }
__host__ __device__ __forceinline__ void stage_rc(int b, int& R, int& C) { const int st = b / 1024, sb = b % 1024, swz = sb ^ (((sb >> 9) & 1) << 5); R = (st >> 1) * 16 + swz / 64; C = (st & 1) * 32 + (swz % 64) / 2; }
__host__ __device__ __forceinline__ int perm32(int rho) { const int n = rho >> 4, i = rho & 15; return 8 * (i >> 2) + 4 * n + (i & 3); }

__device__ __forceinline__ int lane_id() { int l; asm volatile("v_mbcnt_lo_u32_b32 %0, -1, 0\n\tv_mbcnt_hi_u32_b32 %0, -1, %0" : "=v"(l)); return l; }
struct Unit { int pm, pn, aux, om, on; };
struct Gemm { const bf16_t* A; const bf16_t* Bt; int M  , N, K; };

typedef float f32x2 __attribute__((ext_vector_type(2)));
typedef __bf16 bf16x2_t __attribute__((ext_vector_type(2)));
__device__ __forceinline__ unsigned cvt_pk_bf16(float lo, float hi) { f32x2 v = {lo, hi}; bf16x2_t b = __builtin_convertvector(v, bf16x2_t); return __builtin_bit_cast(unsigned, b); }

__device__ __forceinline__ void tile_swz(int L, int nM, int nN, int& pm, int& pn) {
    const int nwg = nM * nN; int wgid = L; { const int q = nwg / NXCD, r = nwg % NXCD, xcd = wgid % NXCD, off = wgid / NXCD; wgid = (xcd < r ? xcd * (q + 1) : r * (q + 1) + (xcd - r) * q) + off; }
    const int nig = WGM * nN, gid = wgid / nig, fm = gid * WGM, gsz = (nM - fm) < WGM ? (nM - fm) : WGM;
    pm = fm + ((wgid % nig) % gsz); pn = (wgid % nig) / gsz;
}
struct Sched2 {
    int nM, nN, G, c;
    __device__ __forceinline__ bool next(int i, Unit& u) const {
        const long L = (long)i * G + c; if (L >= nM * nN) return false;
        tile_swz((int)L, nM, nN, u.pm, u.pn); u.aux = 0; u.om = u.pm; u.on = u.pn; return true;
    }
    __device__ __forceinline__ void a_ready(const Unit&) const {}
    __device__ __forceinline__ void done(const Unit&) const {}
};
struct SchedP1 {
    int TH, TW, G, c;
    __device__ __forceinline__ bool next(int i, Unit& u) const {
        long L = (long)i * G + c;
        if (L < 64 * 72) { tile_swz((int)L, 64, 72, u.om, u.on); u.pm = TH + u.om; u.pn = TW + u.on; u.aux = 0; return true; }
        L -= 64 * 72; if (L < 8 * 64) { tile_swz((int)L, 8, 64, u.om, u.on); u.pm = TW + 76 + u.om; u.pn = TH + u.on; u.aux = 1; return true; }
        return false;
    }
    __device__ __forceinline__ void a_ready(const Unit&) const {}
    __device__ __forceinline__ void done(const Unit&) const {}
};
struct SchedMem {
    int TM, TW0, TWL, G, c;
    __device__ __forceinline__ bool next(int i, Unit& u) const {
        const long L = (long)i * G + c; if (L >= 64) return false;
        const int l2 = (int)L >> 5, t = ((int)L >> 4) & 1, ii = ((int)L >> 2) & 3, jj = (int)L & 3, tw = TW0 + TWL * l2, tm = TM + 4 * l2;
        if (t == 0) { u.pm = tm + ii; u.pn = tw + 72 + jj; } else { u.pm = tw + 84 + ii; u.pn = tm + jj; }
        u.aux = 2 + l2 * 2 + t; u.om = ii; u.on = jj; return true;
    }
    __device__ __forceinline__ void a_ready(const Unit&) const {}
    __device__ __forceinline__ void done(const Unit&) const {}
};
struct SchedBranch {
    int G, c;
    __device__ __forceinline__ bool next(int i, Unit& u) const {
        const int n = i & 3; const long T = (long)(i >> 2) * G + c; if (T >= 512) return false;
        int pm, pn; tile_swz((int)T, 64, 8, pm, pn); u.pm = n * 64 + pm; u.pn = n * 8 + pn; u.aux = n; u.om = pm; u.on = pn; return true;
    }
    __device__ __forceinline__ void a_ready(const Unit&) const {}
    __device__ __forceinline__ void done(const Unit&) const {}
};
struct SchedPool {
    int G, c;
    __device__ __forceinline__ bool next(int i, Unit& u) const {
        const long L = (long)i * G + c; if (L >= 256) return false; u.pm = (int)L; u.pn = (int)L >> 6; u.aux = (int)L >> 6; u.om = (int)L & 63; u.on = 0; return true;
    }
    __device__ __forceinline__ void a_ready(const Unit&) const {}
    __device__ __forceinline__ void done(const Unit&) const {}
};
template <class Epi, class Sched, bool ALIGN_EPI = false, bool SP2 = false>
__device__ __forceinline__ void gemm_phase(PG8_LAS unsigned char* lds, const Gemm g, const Sched& S, const Epi& E) {
    const int tid_ = g.M * 64 + lane_id();
    const int tid = tid_, wid = __builtin_amdgcn_readfirstlane(tid >> 6), lane = tid & 63, wr = wid >> 2, wc = wid & 3, fr = lane & 15, fq = lane >> 4;
    const int K = g.K, nt = K / BK;
    unsigned voffA[2], voffB[2];
#pragma unroll
    for (int i = 0; i < 2; ++i) { int R, C; stage_rc(tid * 16 + i * 8192, R, C); const int Rb = Epi::PERM ? ((R & ~31) + perm32(R & 31)) : R;
        voffA[i] = (unsigned)(R * K + C) * 2u; voffB[i] = (unsigned)(Rb * K + C) * 2u; }
    const size_t kstep = (size_t)(BK * 2);
    const size_t hstep = (size_t)HALF * K * 2;
    const size_t tstep = 2 * hstep;
    const unsigned ldsw = (unsigned)wid * 1024u;
    const int aoff = lds_byte(wr * 64 + fr, fq * 8), boff = lds_byte(wc * 32 + fr, fq * 8);
#define PG8_SA(b, h) (((b) * 2 + (h)) * HTB)
#define PG8_SB(b, h) ((4 + (b) * 2 + (h)) * HTB)
#define PG8_STAGE(bufoff, gbase, voff) do { _Pragma("unroll") for (int _i = 0; _i < 2; ++_i) \
        __builtin_amdgcn_global_load_lds((const unsigned*)((const char*)(gbase) + (voff)[_i]), (PG8_LAS unsigned*)(lds + (bufoff) + ldsw + _i * 8192), 16, 0, 0); } while (0)
#define PG8_LDA(dst, b, h) do { _Pragma("unroll") for (int m = 0; m < 4; ++m) _Pragma("unroll") for (int k = 0; k < 2; ++k) dst[m][k] = *(const PG8_LAS bf16x8*)(lds + PG8_SA(b, h) + aoff + m * 2048 + k * 1024); } while (0)
#define PG8_LDB(dst, b, h) do { _Pragma("unroll") for (int n = 0; n < 2; ++n) _Pragma("unroll") for (int k = 0; k < 2; ++k) dst[n][k] = *(const PG8_LAS bf16x8*)(lds + PG8_SB(b, h) + boff + n * 2048 + k * 1024); } while (0)
#define PG8_MMA(ai, bj, At, Bt) do { __builtin_amdgcn_s_setprio(1); _Pragma("unroll") for (int m = 0; m < 4; ++m) _Pragma("unroll") for (int n = 0; n < 2; ++n) _Pragma("unroll") for (int k = 0; k < 2; ++k) \
        acc[ai][bj][m][n] = __builtin_amdgcn_mfma_f32_16x16x32_bf16(Bt[n][k], At[m][k], acc[ai][bj][m][n], 0, 0, 0); __builtin_amdgcn_s_setprio(0); } while (0)
#define PG8_WAIT_V(n) asm volatile("s_waitcnt vmcnt(" #n ")" ::: "memory")
#define PG8_WAIT_L(n) asm volatile("s_waitcnt lgkmcnt(" #n ")" ::: "memory")
#define PG8_BAR __builtin_amdgcn_s_barrier()
#define PG8_SCHED __builtin_amdgcn_sched_barrier(0)
    Unit cur, nxt; int ui = 0;
    if (!S.next(0, cur)) return;
    f32x4 acc[2][2][4][2];
#pragma unroll
    for (int a = 0; a < 2; ++a)
#pragma unroll
        for (int b = 0; b < 2; ++b)
#pragma unroll
            for (int m = 0; m < 4; ++m)
#pragma unroll
                for (int n = 0; n < 2; ++n) acc[a][b][m][n] = (f32x4){0.f, 0.f, 0.f, 0.f};
    bf16x8 At[4][2], B0[2][2], B1[2][2];
    const char* cA = (const char*)g.A + (size_t)cur.pm * tstep; const char* cB = (const char*)g.Bt + (size_t)cur.pn * tstep;
    S.a_ready(cur);
    if constexpr (SP2) {
        PG8_STAGE(PG8_SB(0, 0), cB, voffB); PG8_STAGE(PG8_SB(0, 1), cB + hstep, voffB); PG8_STAGE(PG8_SA(0, 0), cA, voffA); PG8_STAGE(PG8_SA(0, 1), cA + hstep, voffA);
        if (wr == 1) PG8_BAR;
        PG8_WAIT_V(2); PG8_BAR;
        PG8_STAGE(PG8_SB(1, 0), cB + kstep, voffB); PG8_STAGE(PG8_SA(1, 0), cA + kstep, voffA); PG8_STAGE(PG8_SB(1, 1), cB + hstep + kstep, voffB);
        PG8_WAIT_V(6); PG8_BAR;
    } else {
        PG8_STAGE(PG8_SB(0, 0), cB, voffB); PG8_STAGE(PG8_SA(0, 0), cA, voffA); PG8_STAGE(PG8_SB(0, 1), cB + hstep, voffB); PG8_STAGE(PG8_SA(0, 1), cA + hstep, voffA);
        if (wr == 1) PG8_BAR;
        PG8_WAIT_V(4); PG8_BAR;
        PG8_STAGE(PG8_SB(1, 0), cB + kstep, voffB); PG8_STAGE(PG8_SA(1, 0), cA + kstep, voffA); PG8_STAGE(PG8_SB(1, 1), cB + hstep + kstep, voffB);
        PG8_WAIT_V(6); PG8_BAR;
    }
    for (;;) {
        const bool has_next = S.next(ui + 1, nxt);
        const char* nA = has_next ? (const char*)g.A + (size_t)nxt.pm * tstep : cA; const char* nB = has_next ? (const char*)g.Bt + (size_t)nxt.pn * tstep : cB;
        for (int t = 0; t < nt; t += 2) {
            const bool last = (t == nt - 2);
            const char* a1 = cA + (size_t)(t + 1) * kstep;
            const char* a2 = last ? nA : cA + (size_t)(t + 2) * kstep; const char* b2 = last ? nB : cB + (size_t)(t + 2) * kstep;
            const char* a3 = a2 + kstep; const char* b3 = b2 + kstep;
            if (last && has_next) S.a_ready(nxt);
            if constexpr (SP2) {
            PG8_LDB(B0, 0, 0); PG8_LDB(B1, 0, 1); PG8_SCHED; PG8_LDA(At, 0, 0); PG8_STAGE(PG8_SA(1, 1), a1 + hstep, voffA);
            PG8_WAIT_V(8); PG8_WAIT_L(0); PG8_BAR; PG8_MMA(0, 0, At, B0); PG8_MMA(0, 1, At, B1); PG8_BAR; PG8_SCHED;
            PG8_LDA(At, 0, 1); PG8_STAGE(PG8_SB(0, 0), b2, voffB); PG8_STAGE(PG8_SB(0, 1), b2 + hstep, voffB); PG8_STAGE(PG8_SA(0, 0), a2, voffA);
            PG8_WAIT_V(8); PG8_WAIT_L(0); PG8_BAR; PG8_MMA(1, 0, At, B0); PG8_MMA(1, 1, At, B1); PG8_BAR; PG8_SCHED;
            PG8_LDB(B0, 1, 0); PG8_LDB(B1, 1, 1); PG8_SCHED; PG8_LDA(At, 1, 0); PG8_STAGE(PG8_SA(0, 1), a2 + hstep, voffA);
            PG8_WAIT_V(8); PG8_WAIT_L(0); PG8_BAR; PG8_MMA(0, 0, At, B0); PG8_MMA(0, 1, At, B1); PG8_BAR; PG8_SCHED;
            PG8_LDA(At, 1, 1); PG8_STAGE(PG8_SB(1, 0), b3, voffB); PG8_STAGE(PG8_SB(1, 1), b3 + hstep, voffB); PG8_STAGE(PG8_SA(1, 0), a3, voffA);
            PG8_WAIT_V(8); PG8_WAIT_L(0); PG8_BAR; PG8_MMA(1, 0, At, B0); PG8_MMA(1, 1, At, B1); PG8_BAR; PG8_SCHED;
            } else {
            PG8_LDB(B0, 0, 0); PG8_SCHED; PG8_LDA(At, 0, 0); PG8_STAGE(PG8_SA(1, 1), a1 + hstep, voffA);
            PG8_WAIT_L(8); PG8_BAR; PG8_WAIT_L(0); PG8_MMA(0, 0, At, B0); PG8_BAR; PG8_SCHED;
            PG8_LDB(B1, 0, 1); PG8_STAGE(PG8_SB(0, 0), b2, voffB);
            PG8_BAR; PG8_WAIT_L(0); PG8_MMA(0, 1, At, B1); PG8_BAR;
            PG8_LDA(At, 0, 1); PG8_STAGE(PG8_SA(0, 0), a2, voffA);
            PG8_BAR; PG8_WAIT_L(0); PG8_MMA(1, 0, At, B0); PG8_BAR; PG8_SCHED;
            PG8_STAGE(PG8_SB(0, 1), b2 + hstep, voffB);
            PG8_WAIT_V(6); PG8_BAR; PG8_MMA(1, 1, At, B1); PG8_BAR;
            PG8_LDB(B0, 1, 0); PG8_SCHED; PG8_LDA(At, 1, 0); PG8_STAGE(PG8_SA(0, 1), a2 + hstep, voffA);
            PG8_WAIT_L(8); PG8_BAR; PG8_WAIT_L(0); PG8_MMA(0, 0, At, B0); PG8_BAR; PG8_SCHED;
            PG8_LDB(B1, 1, 1); PG8_STAGE(PG8_SB(1, 0), b3, voffB);
            PG8_BAR; PG8_WAIT_L(0); PG8_MMA(0, 1, At, B1); PG8_BAR;
            PG8_LDA(At, 1, 1); PG8_STAGE(PG8_SA(1, 0), a3, voffA);
            PG8_BAR; PG8_WAIT_L(0); PG8_MMA(1, 0, At, B0); PG8_BAR; PG8_SCHED;
            PG8_STAGE(PG8_SB(1, 1), b3 + hstep, voffB);
            PG8_WAIT_V(6); PG8_BAR; PG8_MMA(1, 1, At, B1); PG8_BAR;
            }
        }
        if constexpr (ALIGN_EPI) { if (wr == 0) PG8_BAR; }
        if constexpr (!Epi::AFTER_DRAIN) { E(acc, cur, wr, wc, fr, fq); S.done(cur); }
        if (!has_next) break;
        if (!(Epi::CHAIN && cur.aux < 3))
#pragma unroll
        for (int a = 0; a < 2; ++a)
#pragma unroll
            for (int b = 0; b < 2; ++b)
#pragma unroll
                for (int m = 0; m < 4; ++m)
#pragma unroll
                    for (int n = 0; n < 2; ++n) acc[a][b][m][n] = (f32x4){0.f, 0.f, 0.f, 0.f};
        cur = nxt; cA = nA; cB = nB; ++ui;
        if constexpr (ALIGN_EPI) { if (wr == 1) PG8_BAR; }
    }
    PG8_WAIT_V(0);
    if constexpr (!ALIGN_EPI) { if (wr == 0) PG8_BAR; }
    PG8_BAR;
    if constexpr (Epi::AFTER_DRAIN) { E.fused(acc, cur, wr, wc, fr, fq, lds, wid, lane); S.done(cur); }
#undef PG8_SA
#undef PG8_SB
#undef PG8_STAGE
#undef PG8_LDA
#undef PG8_LDB
#undef PG8_MMA
#undef PG8_WAIT_V
#undef PG8_WAIT_L
#undef PG8_BAR
#undef PG8_SCHED
}
}

constexpr int DM = 2048, NB = 4, SEQ = 4096, NTOK = NB * SEQ, NMEM = 256, NMEMTOK = NB * NMEM, BW = 1024, DEPTH = 2;
constexpr int INC = 20480;
constexpr int LDP = 18432, C_DAQ = 0, C_DAK = 1024, C_SBQ = 2048, C_SBK = 3072, C_MEMQ = 4096, C_POOLU = 5120, C_DAZ = 6144, C_SBZ = 7168, C_POOLZ = 8192, C_MEMZ = 9216, C_GATE = 10240;
constexpr int R_MK = 18432, R_V = 19456, R_MV = 21504, R_END = 22528;
constexpr float EPS = 1e-6f, LOG2E = 1.4426950408889634f;
constexpr size_t MiB = 1u << 20;
constexpr size_t WS_CTL = 0, WS_WT = 2 * MiB, WT_LAYER = 113 * MiB, WT_BR = 88 * MiB, WT_OUT = 104 * MiB, WT_POOL = 112 * MiB;
constexpr size_t WS_H = 228 * MiB, WS_P = 296 * MiB, WS_VT = 872 * MiB, WS_MK = 936 * MiB, WS_MVT = 938 * MiB, WS_POOLED = 940 * MiB, WS_BR = 972 * MiB, WS_TMP = 1100 * MiB, WS_MEMN = 1228 * MiB, WS_MKV = 1236 * MiB, WS_END = 1244 * MiB;
constexpr int CTL_BAR = 4096  , CTL_ZERO_BYTES = 32768;
constexpr int CTL_Q = 0  , CTL_BTAB = 1024  , CTL_LAM = 2560  ;
constexpr int BT_STRIDE = 132;

namespace pg8 {
__device__ __forceinline__ float bflo(unsigned w) { return __uint_as_float(w << 16); }
__device__ __forceinline__ float bfhi(unsigned w) { return __uint_as_float(w & 0xffff0000u); }
__device__ __forceinline__ float silu_f(float z) { return z * __builtin_amdgcn_rcpf(1.f + __builtin_amdgcn_exp2f(-z * LOG2E)); }
__device__ __forceinline__ float sigm_f(float z) { return __builtin_amdgcn_rcpf(1.f + __builtin_amdgcn_exp2f(-z * LOG2E)); }
struct EpiP1 {
    static constexpr bool PERM = true, AFTER_DRAIN = false, CHAIN = false;
    unsigned char* ws; const float* gate_b; int wv;
    __device__ __forceinline__ void operator()(const f32x4 (&acc)[2][2][4][2], const Unit& u, int wr_, int wc_, int fr_, int fq_) const {
        const int l_ = lane_id(), wid_ = wv, wr = wid_ >> 2, wc = wid_ & 3, fr = l_ & 15, fq = l_ >> 4; (void)wr_; (void)wc_; (void)fr_; (void)fq_;
        bf16_t* base = (bf16_t*)(ws + (u.aux == 0 ? WS_P : u.aux == 1 ? WS_VT : WS_MKV + (size_t)(u.aux - 2) * 2 * MiB));
        const int ldc = u.aux == 0 ? LDP : u.aux == 1 ? NTOK : NMEMTOK;
        const int row0 = u.om * BM + wr * 64 + fr, col0 = u.on * BM + wc * 32 + 8 * fq;
        if ((u.aux == 0) && (u.on >= C_GATE / BM)) {
            f32x4 gbv[2][2];
#pragma unroll
            for (int bj = 0; bj < 2; ++bj) { const float* gb = gate_b + (col0 + bj * HALF - C_GATE); gbv[bj][0] = *(const f32x4*)gb; gbv[bj][1] = *(const f32x4*)(gb + 4); }
#pragma unroll
            for (int ai = 0; ai < 2; ++ai)
#pragma unroll
                for (int m = 0; m < 4; ++m) { bf16_t* rowp = base + (size_t)(row0 + ai * HALF + m * 16) * ldc + col0;
#pragma unroll
                    for (int bj = 0; bj < 2; ++bj) { f32x4 v0 = acc[ai][bj][m][0], v1 = acc[ai][bj][m][1];
#pragma unroll
                        for (int i = 0; i < 4; ++i) { v0[i] = sigm_f(fmaxf(v0[i] + gbv[bj][0][i], -30.f)); v1[i] = sigm_f(fmaxf(v1[i] + gbv[bj][1][i], -30.f)); }
                        u32x4 w; w.x = cvt_pk_bf16(v0[0], v0[1]); w.y = cvt_pk_bf16(v0[2], v0[3]); w.z = cvt_pk_bf16(v1[0], v1[1]); w.w = cvt_pk_bf16(v1[2], v1[3]);
                        *(u32x4*)(rowp + bj * HALF) = w; } }
        } else {
#pragma unroll
            for (int ai = 0; ai < 2; ++ai)
#pragma unroll
                for (int m = 0; m < 4; ++m) { bf16_t* rowp = base + (size_t)(row0 + ai * HALF + m * 16) * ldc + col0;
#pragma unroll
                    for (int bj = 0; bj < 2; ++bj) { const f32x4 v0 = acc[ai][bj][m][0], v1 = acc[ai][bj][m][1];
                        u32x4 w; w.x = cvt_pk_bf16(v0[0], v0[1]); w.y = cvt_pk_bf16(v0[2], v0[3]); w.z = cvt_pk_bf16(v1[0], v1[1]); w.w = cvt_pk_bf16(v1[2], v1[3]);
                        *(u32x4*)(rowp + bj * HALF) = w; } }
        }
    }
};
struct EpiPool {
    static constexpr bool PERM = true, AFTER_DRAIN = false, CHAIN = false;
    const bf16_t* P; const float* pscale; bf16_t* br2; int wv;
    __device__ __forceinline__ void operator()(const f32x4 (&acc)[2][2][4][2], const Unit& u, int wr_, int wc_, int fr_, int fq_) const {
        const int l_ = lane_id(), wid_ = wv, wr = wid_ >> 2, wc = wid_ & 3, fr = l_ & 15, fq = l_ >> 4; (void)wr_; (void)wc_; (void)fr_; (void)fq_;
        const int g = u.aux, row0 = (u.pm - 64 * g) * BM + wr * 64 + fr, colb = wc * 32 + 8 * fq;
        f32x4 sc[2][2];
#pragma unroll
        for (int bj = 0; bj < 2; ++bj) { sc[bj][0] = *(const f32x4*)(pscale + g * 256 + colb + bj * HALF); sc[bj][1] = *(const f32x4*)(pscale + g * 256 + colb + bj * HALF + 4); }
#pragma unroll
        for (int ai = 0; ai < 2; ++ai) {
            u32x4 zz[4][2];
#pragma unroll
            for (int m = 0; m < 4; ++m)
#pragma unroll
                for (int bj = 0; bj < 2; ++bj) zz[m][bj] = *(const u32x4*)(P + (size_t)(row0 + ai * HALF + m * 16) * LDP + C_POOLZ + g * 256 + colb + bj * HALF);
#pragma unroll
            for (int m = 0; m < 4; ++m) { const int tok = row0 + ai * HALF + m * 16;
#pragma unroll
                for (int bj = 0; bj < 2; ++bj) { const int ch = g * 256 + colb + bj * HALF;
                    const u32x4 z = zz[m][bj]; const f32x4 s0 = sc[bj][0], s1 = sc[bj][1];
                    const f32x4 v0 = acc[ai][bj][m][0], v1 = acc[ai][bj][m][1];
                    u32x4 w;
                    w.x = cvt_pk_bf16(v0[0] * s0[0] * silu_f(bflo(z.x)), v0[1] * s0[1] * silu_f(bfhi(z.x)));
                    w.y = cvt_pk_bf16(v0[2] * s0[2] * silu_f(bflo(z.y)), v0[3] * s0[3] * silu_f(bfhi(z.y)));
                    w.z = cvt_pk_bf16(v1[0] * s1[0] * silu_f(bflo(z.z)), v1[1] * s1[1] * silu_f(bfhi(z.z)));
                    w.w = cvt_pk_bf16(v1[2] * s1[2] * silu_f(bflo(z.w)), v1[3] * s1[3] * silu_f(bfhi(z.w)));
                    *(u32x4*)(br2 + (size_t)tok * BW + ch) = w; } }
            asm volatile("" ::: "memory"); }
    }
};
struct EpiMergeChain {
    static constexpr bool PERM = true, AFTER_DRAIN = false, CHAIN = true;
    const bf16_t* P; bf16_t* merged; int wv;
    __device__ __forceinline__ void operator()(f32x4 (&acc)[2][2][4][2], const Unit& u, int wr_, int wc_, int fr_, int fq_) const {
        const int l_ = lane_id(), wid_ = wv, wr = wid_ >> 2, wc = wid_ & 3, fr = l_ & 15, fq = l_ >> 4; (void)wr_; (void)wc_; (void)fr_; (void)fq_;
        const int n = u.aux, row0 = u.om * BM + wr * 64 + fr, col0 = u.on * BM + wc * 32 + 8 * fq;
        const bf16_t* gbase = P + (size_t)row0 * LDP + C_GATE + n * DM + col0;
        if (n < 3) {
#pragma unroll
            for (int ai = 0; ai < 2; ++ai) {
                u32x4 gaa[4][2], gbb[4][2];
#pragma unroll
                for (int m = 0; m < 4; ++m)
#pragma unroll
                    for (int bj = 0; bj < 2; ++bj) { const bf16_t* gp = gbase + (size_t)(ai * HALF + m * 16) * LDP + bj * HALF; gaa[m][bj] = *(const u32x4*)gp; gbb[m][bj] = *(const u32x4*)(gp + DM); }
#pragma unroll
                for (int m = 0; m < 4; ++m)
#pragma unroll
                    for (int bj = 0; bj < 2; ++bj) { const u32x4 ga = gaa[m][bj], gb = gbb[m][bj]; f32x4 a0 = acc[ai][bj][m][0], a1 = acc[ai][bj][m][1];
                        a0[0] *= bflo(ga.x) * __builtin_amdgcn_rcpf(bflo(gb.x)); a0[1] *= bfhi(ga.x) * __builtin_amdgcn_rcpf(bfhi(gb.x));
                        a0[2] *= bflo(ga.y) * __builtin_amdgcn_rcpf(bflo(gb.y)); a0[3] *= bfhi(ga.y) * __builtin_amdgcn_rcpf(bfhi(gb.y));
                        a1[0] *= bflo(ga.z) * __builtin_amdgcn_rcpf(bflo(gb.z)); a1[1] *= bfhi(ga.z) * __builtin_amdgcn_rcpf(bfhi(gb.z));
                        a1[2] *= bflo(ga.w) * __builtin_amdgcn_rcpf(bflo(gb.w)); a1[3] *= bfhi(ga.w) * __builtin_amdgcn_rcpf(bfhi(gb.w));
                        acc[ai][bj][m][0] = a0; acc[ai][bj][m][1] = a1; }
                asm volatile("" ::: "memory"); }
        } else {
#pragma unroll
            for (int ai = 0; ai < 2; ++ai) {
                u32x4 gaa[4][2];
#pragma unroll
                for (int m = 0; m < 4; ++m)
#pragma unroll
                    for (int bj = 0; bj < 2; ++bj) gaa[m][bj] = *(const u32x4*)(gbase + (size_t)(ai * HALF + m * 16) * LDP + bj * HALF);
#pragma unroll
                for (int m = 0; m < 4; ++m)
#pragma unroll
                    for (int bj = 0; bj < 2; ++bj) { const u32x4 ga = gaa[m][bj]; const f32x4 a0 = acc[ai][bj][m][0], a1 = acc[ai][bj][m][1];
                        u32x4 w; w.x = cvt_pk_bf16(a0[0] * bflo(ga.x), a0[1] * bfhi(ga.x)); w.y = cvt_pk_bf16(a0[2] * bflo(ga.y), a0[3] * bfhi(ga.y));
                        w.z = cvt_pk_bf16(a1[0] * bflo(ga.z), a1[1] * bfhi(ga.z)); w.w = cvt_pk_bf16(a1[2] * bflo(ga.w), a1[3] * bfhi(ga.w));
                        *(u32x4*)(merged + (size_t)(row0 + ai * HALF + m * 16) * DM + col0 + bj * HALF) = w; }
                asm volatile("" ::: "memory"); }
        }
    }
};
struct EpiOut {
    static constexpr bool PERM = true, AFTER_DRAIN = false, CHAIN = false;
    const float* xin; float* xout; int wv;
    __device__ __forceinline__ void operator()(const f32x4 (&acc)[2][2][4][2], const Unit& u, int wr_, int wc_, int fr_, int fq_) const {
        const int l_ = lane_id(), wid_ = wv, wr = wid_ >> 2, wc = wid_ & 3, fr = l_ & 15, fq = l_ >> 4; (void)wr_; (void)wc_; (void)fr_; (void)fq_;
        const int row0 = u.pm * BM + wr * 64 + fr, col0 = u.pn * BM + wc * 32 + 8 * fq;
#pragma unroll
        for (int ai = 0; ai < 2; ++ai) {
            f32x4 xr[4][2][2];
#pragma unroll
            for (int m = 0; m < 4; ++m)
#pragma unroll
                for (int bj = 0; bj < 2; ++bj) { const size_t off = (size_t)(row0 + ai * HALF + m * 16) * DM + col0 + bj * HALF; xr[m][bj][0] = *(const f32x4*)(xin + off); xr[m][bj][1] = *(const f32x4*)(xin + off + 4); }
#pragma unroll
            for (int m = 0; m < 4; ++m)
#pragma unroll
                for (int bj = 0; bj < 2; ++bj) { const size_t off = (size_t)(row0 + ai * HALF + m * 16) * DM + col0 + bj * HALF;
                    *(f32x4*)(xout + off) = xr[m][bj][0] + acc[ai][bj][m][0]; *(f32x4*)(xout + off + 4) = xr[m][bj][1] + acc[ai][bj][m][1]; }
            asm volatile("" ::: "memory"); }
    }
};
}

#define LAS __attribute__((address_space(3)))
typedef unsigned short bf16_t;
typedef short bf16x8 __attribute__((ext_vector_type(8)));
typedef float f32x4 __attribute__((ext_vector_type(4)));
typedef float f32x16 __attribute__((ext_vector_type(16)));
typedef unsigned u32x4 __attribute__((ext_vector_type(4)));
typedef unsigned u32x2 __attribute__((ext_vector_type(2)));
using pg8::cvt_pk_bf16; using pg8::bflo; using pg8::bfhi; using pg8::silu_f;
constexpr int NWAVES = 8, NTHR = 512;
constexpr int RING_BYTES = 131072, MISC_OFF = RING_BYTES, LDS_BYTES = 147456;
#define LDS_WAIT() asm volatile("s_waitcnt lgkmcnt(0)" ::: "memory")

struct Params {
    const float* x; const float* mem; const float* rel_bias; const float* norm_g; const float* w_in; const float* gate_b;
    const float* lq1; const float* lk1; const float* lq2; const float* lk2; const float* da_norm_g; const float* w_pool; const float* pool_scale;
    const float* mem_norm_g; const float* w_mem_kv; const float* w_branch; const float* w_out; const float* final_g;
    float* out; unsigned char* ws;
};

#define GAS __attribute__((address_space(1)))
#define XB_TMO      128
#define XB_XCNT(j)  (256  + 64 * (j))
#define XB_XSUB(j)  (1280 + 64 * (j))
#define XB_XGEN(j)  (2304 + 64 * (j))
#define XB_TOP      3328
#define XB_TOPGEN   3392
#define XCD_BAR_WORDS 3456
#define XB_SPIN_CAP (1u << 18)

__device__ __forceinline__ unsigned xb_ld(unsigned* p)              { return __hip_atomic_load(p, __ATOMIC_RELAXED, __HIP_MEMORY_SCOPE_AGENT); }
__device__ __forceinline__ unsigned xb_add(unsigned* p, unsigned v) { return __hip_atomic_fetch_add(p, v, __ATOMIC_RELAXED, __HIP_MEMORY_SCOPE_AGENT); }
__device__ __forceinline__ unsigned xb_xcc_id() { return (unsigned)__builtin_amdgcn_s_getreg((3 << 11) | 20) & 0xFu; }
#define XB_SPIN(cond, bar) do { unsigned _sp = 0; while (cond) { __builtin_amdgcn_s_sleep(1); \
    if ((++_sp & 255u) == 0u) { if (xb_ld(&(bar)[XB_TMO])) break; if (_sp > XB_SPIN_CAP) { atomicAdd(&(bar)[XB_TMO], 1u); break; } } } } while (0)

struct XcdBarrier {
    unsigned* bar; unsigned x; int wv;
    volatile LAS unsigned* st;
};

__device__ __forceinline__ XcdBarrier xcd_barrier_post(unsigned* bar, volatile LAS unsigned* st) {
    XcdBarrier b; b.bar = bar; b.x = xb_xcc_id(); b.st = st;
    if (threadIdx.x == 0) (void)xb_add(&bar[XB_XCNT(b.x)], 1u);
    return b;
}
__device__ __forceinline__ void xcd_barrier_complete(unsigned* bar, unsigned x, unsigned& nloc, unsigned& nx) {
    const unsigned G = gridDim.x * gridDim.y * gridDim.z;
    unsigned sum, cnt, mine, sp = 0u;
    for (;;) {
        sum = 0u; cnt = 0u; mine = 0u;
#pragma unroll
        for (unsigned j = 0; j < 16; ++j) { const unsigned c = xb_ld(&bar[XB_XCNT(j)]); sum += c; cnt += (c > 0u) ? 1u : 0u; mine = (j == x) ? c : mine; }
        if (sum == G) break;
        __builtin_amdgcn_s_sleep(1);
        if ((++sp & 255u) == 0u) { if (xb_ld(&bar[XB_TMO])) break; if (sp > XB_SPIN_CAP) { atomicAdd(&bar[XB_TMO], 1u); break; } }
    }
    nloc = mine > 0u ? mine : 1u; nx = cnt > 0u ? cnt : 1u;
}

__device__ __forceinline__ void xcd_barrier(const XcdBarrier& b) {
    asm volatile("s_waitcnt vmcnt(0)" ::: "memory");
    __syncthreads();
    if (b.wv == 0 && pg8::lane_id() == 0) {
        unsigned* bar = b.bar;
        __builtin_amdgcn_s_waitcnt(0);
        unsigned nloc = b.st[0], nx = b.st[1];
        if (nloc == 0u) { xcd_barrier_complete(bar, b.x, nloc, nx); b.st[0] = nloc; b.st[1] = nx; }
        const unsigned old = xb_add(&bar[XB_XSUB(b.x)], 1u);
        const unsigned gen = old / nloc;
        if (old + 1u == (gen + 1u) * nloc) {
            __builtin_amdgcn_fence(__ATOMIC_RELEASE, "agent");
            asm volatile("s_waitcnt vmcnt(0)" ::: "memory");
            const unsigned og = xb_add(&bar[XB_TOP], 1u);
            const unsigned tg = og / nx;
            if (og + 1u == (tg + 1u) * nx) xb_add(&bar[XB_TOPGEN], 1u);
            else XB_SPIN(xb_ld(&bar[XB_TOPGEN]) == tg, bar);
            __builtin_amdgcn_fence(__ATOMIC_ACQUIRE, "agent");
            xb_add(&bar[XB_XGEN(b.x)], 1u);
            asm volatile("s_waitcnt vmcnt(0)" ::: "memory");
        } else {
            XB_SPIN(xb_ld(&bar[XB_XGEN(b.x)]) == gen, bar);
            __builtin_amdgcn_fence(__ATOMIC_ACQUIRE, "agent");
            asm volatile("s_waitcnt vmcnt(0)" ::: "memory");
        }
    }
    __syncthreads();
}

__device__ __forceinline__ const Params* kparams() { auto kp = __builtin_amdgcn_kernarg_segment_ptr(); asm volatile("" : "+s"(kp)); return (const Params*)kp; }
__device__ __forceinline__ float wave_sum(float v, int lane) {
#pragma unroll
    for (int o = 1; o < 64; o <<= 1) v += __int_as_float(__builtin_amdgcn_ds_bpermute((lane ^ o) << 2, __float_as_int(v)));
    return v;
}
__device__ __forceinline__ void transpose_item(const float* W, int K, int N, bf16_t* WT, long row_off, LAS float* scr, int kb, int nb, int lane) {
    const int k0 = 64 * kb, n0 = 32 * nb;
    float wv[32];
#pragma unroll
    for (int i = 0; i < 32; ++i) wv[i] = W[(size_t)(k0 + 2 * i + (lane >> 5)) * N + n0 + (lane & 31)];
#pragma unroll
    for (int i = 0; i < 32; ++i) scr[(2 * i + (lane >> 5)) * 33 + (lane & 31)] = wv[i];
    LDS_WAIT(); asm volatile("" ::: "memory");
    const int c = lane & 7;
#pragma unroll
    for (int j = 0; j < 4; ++j) { const int n = (lane >> 3) + 8 * j; const LAS float* s = scr + (8 * c) * 33 + n;
        u32x4 o; o.x = cvt_pk_bf16(s[0 * 33], s[1 * 33]); o.y = cvt_pk_bf16(s[2 * 33], s[3 * 33]); o.z = cvt_pk_bf16(s[4 * 33], s[5 * 33]); o.w = cvt_pk_bf16(s[6 * 33], s[7 * 33]);
        *(u32x4*)(WT + (size_t)(row_off + n0 + n) * K + k0 + 8 * c) = o; }
    LDS_WAIT(); asm volatile("" ::: "memory");
}
__device__ __forceinline__ int win_dest_row(int n0) {
    if (n0 >= 12288) return C_GATE + (n0 - 12288);
    const int s = n0 >> 10, r = n0 & 1023;
    const int base = s == 0 ? C_DAQ : s == 1 ? C_DAK : s == 2 ? R_V : s == 3 ? C_DAZ : s == 4 ? C_SBQ : s == 5 ? C_SBK : s == 6 ? R_V + 1024 : s == 7 ? C_SBZ : s == 8 ? C_POOLU : s == 9 ? C_POOLZ : s == 10 ? C_MEMQ : C_MEMZ;
    return base + r;
}
__device__ __forceinline__ void convert_weights(const Params& p, LAS unsigned char* lds, int gw, int NGW, int wave, int lane) {
    LAS float* scr = (LAS float*)(lds + wave * 16384);
    constexpr int I_IN = 32 * 640, I_KV = 32 * 64, I_BR = 4 * 16 * 64, I_OUT = 32 * 64, I_POOL = 4 * 4 * 8, I_LAYER = I_IN + I_KV + I_BR + I_OUT + I_POOL;
    for (int it = gw; it < DEPTH * I_LAYER; it += NGW) {
        const int l = it / I_LAYER; int r = it % I_LAYER;
        bf16_t* wt = (bf16_t*)(p.ws + WS_WT + (size_t)l * WT_LAYER);
        if (r < I_IN) { const int kb = r / 640, nb = r % 640, n0 = nb * 32; transpose_item(p.w_in + (size_t)l * DM * INC, DM, INC, wt, (long)win_dest_row(n0) - n0, scr, kb, nb, lane); continue; } r -= I_IN;
        if (r < I_KV) { const int kb = r / 64, nb = r % 64, n0 = nb * 32; transpose_item(p.w_mem_kv + (size_t)l * DM * 2048, DM, 2048, wt, n0 < 1024 ? R_MK : R_MV - 1024, scr, kb, nb, lane); continue; } r -= I_KV;
        if (r < I_BR) { const int n = r / 1024, q = r % 1024, kb = q / 64, nb = q % 64; transpose_item(p.w_branch + ((size_t)l * 4 + n) * BW * DM, BW, DM, (bf16_t*)(p.ws + WS_WT + (size_t)l * WT_LAYER + WT_BR) + (size_t)n * DM * BW, 0, scr, kb, nb, lane); continue; } r -= I_BR;
        if (r < I_OUT) { const int kb = r / 64, nb = r % 64; transpose_item(p.w_out + (size_t)l * DM * DM, DM, DM, (bf16_t*)(p.ws + WS_WT + (size_t)l * WT_LAYER + WT_OUT), 0, scr, kb, nb, lane); continue; } r -= I_OUT;
        { const int g = r / 32, q = r % 32, kb = q / 8, nb = q % 8; transpose_item(p.w_pool + ((size_t)l * 4 + g) * 256 * 256, 256, 256, (bf16_t*)(p.ws + WS_WT + (size_t)l * WT_LAYER + WT_POOL) + (size_t)g * 256 * 256, 0, scr, kb, nb, lane); }
    }
}
__device__ __forceinline__ void rms_row_bf16(const float* xrow, const float* g, bf16_t* orow, int lane) {
    const f32x4* xr = (const f32x4*)xrow + lane; const f32x4* gr = (const f32x4*)g + lane;
    f32x4 v[8]; float s = 0.f;
#pragma unroll
    for (int j = 0; j < 8; ++j) { v[j] = xr[64 * j]; s += (v[j].x * v[j].x + v[j].y * v[j].y) + (v[j].z * v[j].z + v[j].w * v[j].w); }
    const float rstd = 1.f / sqrtf(wave_sum(s, lane) * (1.f / DM) + EPS);
    u32x2* o8 = (u32x2*)orow + lane;
#pragma unroll
    for (int j = 0; j < 8; ++j) { const f32x4 gg = gr[64 * j]; u32x2 w; w.x = cvt_pk_bf16(v[j].x * rstd * gg.x, v[j].y * rstd * gg.y); w.y = cvt_pk_bf16(v[j].z * rstd * gg.z, v[j].w * rstd * gg.w); o8[64 * j] = w; }
}
__device__ __forceinline__ void rms_rows2_bf16(const float* x0, const float* x1, const float* g, bf16_t* o0, bf16_t* o1, int lane) {
    const f32x4* xa = (const f32x4*)x0 + lane; const f32x4* xb = (const f32x4*)x1 + lane; const f32x4* gr = (const f32x4*)g + lane;
    f32x4 va[8], vb[8], gg[8]; float sa = 0.f, sb = 0.f;
#pragma unroll
    for (int j = 0; j < 8; ++j) { va[j] = xa[64 * j]; vb[j] = xb[64 * j]; gg[j] = gr[64 * j]; }
#pragma unroll
    for (int j = 0; j < 8; ++j) { sa += (va[j].x * va[j].x + va[j].y * va[j].y) + (va[j].z * va[j].z + va[j].w * va[j].w); sb += (vb[j].x * vb[j].x + vb[j].y * vb[j].y) + (vb[j].z * vb[j].z + vb[j].w * vb[j].w); }
    const float ra = 1.f / sqrtf(wave_sum(sa, lane) * (1.f / DM) + EPS), rb = 1.f / sqrtf(wave_sum(sb, lane) * (1.f / DM) + EPS);
    u32x2* pa = (u32x2*)o0 + lane; u32x2* pb = (u32x2*)o1 + lane;
#pragma unroll
    for (int j = 0; j < 8; ++j) { u32x2 w; w.x = cvt_pk_bf16(va[j].x * ra * gg[j].x, va[j].y * ra * gg[j].y); w.y = cvt_pk_bf16(va[j].z * ra * gg[j].z, va[j].w * ra * gg[j].w); pa[64 * j] = w;
        w.x = cvt_pk_bf16(vb[j].x * rb * gg[j].x, vb[j].y * rb * gg[j].y); w.y = cvt_pk_bf16(vb[j].z * rb * gg[j].z, vb[j].w * rb * gg[j].w); pb[64 * j] = w; }
}
__device__ __forceinline__ void norm_phase(const Params& p, int l, const float* xsrc, int gw, int NGW, int lane) {
    bf16_t* H = (bf16_t*)(p.ws + WS_H); bf16_t* MN = (bf16_t*)(p.ws + WS_MEMN);
    int m = gw;
    for (; m + NGW < NTOK; m += 2 * NGW) rms_rows2_bf16(xsrc + (size_t)m * DM, xsrc + (size_t)(m + NGW) * DM, p.norm_g + l * DM, H + (size_t)m * DM, H + (size_t)(m + NGW) * DM, lane);
    if (m < NTOK) rms_row_bf16(xsrc + (size_t)m * DM, p.norm_g + l * DM, H + (size_t)m * DM, lane);
    if (l == 0)
        for (int mm = gw; mm < 2 * NMEMTOK; mm += NGW) { const int l2 = mm >> 10, r = mm & 1023; rms_row_bf16(p.mem + (size_t)r * DM, p.mem_norm_g + l2 * DM, MN + (size_t)mm * DM, lane); }
}
__device__ __forceinline__ void final_norm_phase(const Params& p, int gw, int NGW, int lane) {
    const f32x4* gr = (const f32x4*)p.final_g + lane;
    int m = gw;
    for (; m + NGW < NTOK; m += 2 * NGW) {
        f32x4* xa = (f32x4*)(p.out + (size_t)m * DM) + lane; f32x4* xb = (f32x4*)(p.out + (size_t)(m + NGW) * DM) + lane;
        f32x4 va[8], vb[8], gg[8]; float sa = 0.f, sb = 0.f;
#pragma unroll
        for (int j = 0; j < 8; ++j) { va[j] = xa[64 * j]; vb[j] = xb[64 * j]; gg[j] = gr[64 * j]; }
#pragma unroll
        for (int j = 0; j < 8; ++j) { sa += (va[j].x * va[j].x + va[j].y * va[j].y) + (va[j].z * va[j].z + va[j].w * va[j].w); sb += (vb[j].x * vb[j].x + vb[j].y * vb[j].y) + (vb[j].z * vb[j].z + vb[j].w * vb[j].w); }
        const float ra = 1.f / sqrtf(wave_sum(sa, lane) * (1.f / DM) + EPS), rb = 1.f / sqrtf(wave_sum(sb, lane) * (1.f / DM) + EPS);
#pragma unroll
        for (int j = 0; j < 8; ++j) { xa[64 * j] = va[j] * ra * gg[j]; xb[64 * j] = vb[j] * rb * gg[j]; }
    }
    if (m < NTOK) {
        f32x4* xr = (f32x4*)(p.out + (size_t)m * DM) + lane;
        f32x4 v[8]; float s = 0.f;
#pragma unroll
        for (int j = 0; j < 8; ++j) { v[j] = xr[64 * j]; s += (v[j].x * v[j].x + v[j].y * v[j].y) + (v[j].z * v[j].z + v[j].w * v[j].w); }
        const float rstd = 1.f / sqrtf(wave_sum(s, lane) * (1.f / DM) + EPS);
#pragma unroll
        for (int j = 0; j < 8; ++j) xr[64 * j] = v[j] * rstd * gr[64 * j];
    }
}
__device__ __forceinline__ void pooled_phase(const Params& p, int gtid, int NGT) {
    if (gtid < 0) return;
    const bf16_t* __restrict__ P = (const bf16_t*)(p.ws + WS_P); bf16_t* __restrict__ PO = (bf16_t*)(p.ws + WS_POOLED);
#pragma unroll 2
    for (int it = gtid; it < NTOK * 128; it += NGT) {
        const int tok = it >> 7, ch = (it & 127) * 8, g = ch >> 8, w = 2 << g, s = tok & (SEQ - 1), cnt = (s + 1) < w ? (s + 1) : w;
        float a[8];
#pragma unroll
        for (int i = 0; i < 8; ++i) a[i] = 0.f;
        u32x4 uu[16];
#pragma unroll
        for (int j = 0; j < 16; ++j) { uu[j] = (u32x4){0u, 0u, 0u, 0u}; if (j < cnt) uu[j] = *(const u32x4*)(P + (size_t)(tok - j) * LDP + C_POOLU + ch); }
        const u32x4 u0 = uu[0];
#pragma unroll
        for (int j = 0; j < 16; ++j) { const u32x4 u = uu[j];
            a[0] += bflo(u.x); a[1] += bfhi(u.x); a[2] += bflo(u.y); a[3] += bfhi(u.y); a[4] += bflo(u.z); a[5] += bfhi(u.z); a[6] += bflo(u.w); a[7] += bfhi(u.w); }
        const float ic = 1.f / (float)cnt;
        u32x4 o; o.x = cvt_pk_bf16(a[0] * ic - bflo(u0.x), a[1] * ic - bfhi(u0.x)); o.y = cvt_pk_bf16(a[2] * ic - bflo(u0.y), a[3] * ic - bfhi(u0.y));
        o.z = cvt_pk_bf16(a[4] * ic - bflo(u0.z), a[5] * ic - bfhi(u0.z)); o.w = cvt_pk_bf16(a[6] * ic - bflo(u0.w), a[7] * ic - bfhi(u0.w));
        *(u32x4*)(PO + ((size_t)g * NTOK + tok) * 256 + (ch & 255)) = o;
    }
}
namespace att {
constexpr int VPITCH = 144, VBUF = 128 * VPITCH, O0_OFF = 2 * (64 * 144 + VBUF);
static_assert(2 * (64 * 528 + VBUF) <= RING_BYTES && O0_OFF + 65536 <= RING_BYTES, "attention LDS");
#define MFMA32(a, b, c) __builtin_amdgcn_mfma_f32_32x32x16_bf16((a), (b), (c), 0, 0, 0)
#define EX2(x) __builtin_amdgcn_exp2f(x)
#define LG2(x) __builtin_amdgcn_logf(x)

__device__ __forceinline__ float xhalf(float v) {
    const unsigned u = __float_as_uint(v); auto rr = __builtin_amdgcn_permlane32_swap(u, u, false, false); return __uint_as_float(rr[0] == u ? rr[1] : rr[0]); }
template <int DQK, int MODE, int NDT, int PF>
__device__ __forceinline__ void flash_pass(LAS unsigned char* lds, const bf16_t* Kg, int ldk, const bf16_t* Vg, int ldv, const bf16x8 (&qf)[DQK / 16], int NT, int qsw_min, float sc2,
                                           const LAS float* btab, f32x16 (&o)[NDT], float& m_run, float& l_run, int wv) {
    const int tid_ = wv * 64 + pg8::lane_id();
    const int tid = tid_, lane = tid & 63, r32 = lane & 31, hi = lane >> 5;
    constexpr int KP = DQK * 2 + 16, KPR = DQK / 8, KPT = DQK / 64, KBUF = 64 * KP, BUF = KBUF + VBUF, VPT = NDT / 2;
    const int qsw_max = qsw_min + 31, qs = qsw_min + r32;
    const int pm = (r32 & 0x13) | ((r32 & 4) << 1) | ((r32 & 8) >> 1);
    u32x4 kreg[PF][KPT], vreg[PF][VPT];
#define TILE(J) ((MODE == 1) ? NT - 1 - (J) : (J))
#define GLOAD(J, S) do { const int kt_ = TILE(J); _Pragma("unroll") for (int i_ = 0; i_ < KPT; ++i_) { const int p_ = tid + 512 * i_, row_ = p_ / KPR, cp_ = p_ % KPR; kreg[S][i_] = *(const u32x4*)(Kg + (size_t)(64 * kt_ + row_) * ldk + cp_ * 8); } \
    _Pragma("unroll") for (int i_ = 0; i_ < VPT; ++i_) { const int p_ = tid + 512 * i_, row_ = p_ >> 3, cp_ = p_ & 7; vreg[S][i_] = *(const u32x4*)(Vg + (size_t)row_ * ldv + 64 * kt_ + cp_ * 8); } } while (0)
#define LSTORE(B, S) do { _Pragma("unroll") for (int i_ = 0; i_ < KPT; ++i_) { const int p_ = tid + 512 * i_, row_ = p_ / KPR, cp_ = p_ % KPR; *(LAS u32x4*)(lds + (B) * BUF + row_ * KP + cp_ * 16) = kreg[S][i_]; } \
    _Pragma("unroll") for (int i_ = 0; i_ < VPT; ++i_) { const int p_ = tid + 512 * i_, row_ = p_ >> 3, cp_ = p_ & 7; *(LAS u32x4*)(lds + (B) * BUF + KBUF + row_ * VPITCH + cp_ * 16) = vreg[S][i_]; } } while (0)
#pragma unroll
    for (int j = 0; j < PF; ++j) if (j < NT) GLOAD(j, j);
    LSTORE(0, 0); if (PF < NT) GLOAD(PF, 0);
    __syncthreads();
    float R = 0.f; bool wave_done = false, all_done = false;
    float off_far = (MODE == 0) ? btab[128] - m_run : -m_run;
    LAS unsigned* dflag = (LAS unsigned*)(lds + MISC_OFF + 64);
    for (int it0 = 0; it0 < NT && !all_done; it0 += PF) {
#pragma unroll
    for (int u_ = 0; u_ < PF; ++u_) { const int it = it0 + u_;
      if (it < NT && !all_done) {
        const int kt = TILE(it);
        if (it + 1 < NT) { LSTORE((it + 1) & 1, (u_ + 1) % PF); if (it + 1 + PF < NT) GLOAD(it + 1 + PF, (u_ + 1) % PF); }
        const LAS unsigned char* kb = lds + (it & 1) * BUF; const LAS unsigned char* vb = kb + KBUF;
        const bool relevant = (MODE == 2) ? true : (MODE == 0 ? (64 * kt <= qsw_max) : ((64 * kt <= qsw_max - 1) && !wave_done));
        if (relevant) {
            f32x16 s[2];
#pragma unroll
            for (int st = 0; st < 2; ++st)
#pragma unroll
                for (int r = 0; r < 16; ++r) s[st][r] = 0.f;
            constexpr int DG = DQK / 64, NG = 2 * DG;
            constexpr bool PIPE = (MODE != 2); constexpr int NFB = PIPE ? 2 : 1;
            bf16x8 kf[NFB][4], vf[NFB][4];
#define KLOAD(g_, b_) do { _Pragma("unroll") for (int j_ = 0; j_ < 4; ++j_) kf[b_][j_] = *(const LAS bf16x8*)(kb + (32 * (j_ & 1) + pm) * KP + (16 * (2 * (g_) + (j_ >> 1)) + 8 * hi) * 2); } while (0)
#define VLOAD(dt_, b_) do { _Pragma("unroll") for (int j_ = 0; j_ < 4; ++j_) vf[b_][j_] = *(const LAS bf16x8*)(vb + (32 * (dt_) + r32) * VPITCH + (16 * j_ + 8 * hi) * 2); } while (0)
#define VLOADC(c_, b_) do { _Pragma("unroll") for (int j_ = 0; j_ < NDT; ++j_) vf[b_][j_] = *(const LAS bf16x8*)(vb + (32 * j_ + r32) * VPITCH + (16 * (c_) + 8 * hi) * 2); } while (0)
            if (PIPE) KLOAD(0, 0);
#pragma unroll
            for (int g = 0; g < NG; ++g) {
                __builtin_amdgcn_sched_barrier(0);
                if (PIPE) { if (g + 1 < NG) KLOAD(g + 1, (g + 1) & (NFB - 1)); else if (MODE == 1) VLOAD(0, 0); else VLOADC(0, 0); } else KLOAD(g, 0);
#pragma unroll
                for (int j = 0; j < 4; ++j) s[j & 1] = MFMA32(kf[g & (NFB - 1)][j], qf[2 * g + (j >> 1)], s[j & 1]);
            }
            __builtin_amdgcn_sched_barrier(0);
            int d0 = qs - 64 * kt - 8 * hi; asm volatile("" : "+v"(d0));
            if (MODE == 1) {
                const bool needmask = (64 * kt + 63 >= qsw_min);
#pragma unroll
                for (int st = 1; st >= 0; --st) {
                    float sp[16];
#pragma unroll
                    for (int r = 0; r < 16; ++r) { const float z2 = s[st][r] * sc2; s[st][r] = z2; float v = fmaxf(z2, 0.f) + LG2(1.f + EX2(-fabsf(z2)));
                        if (needmask) { if ((32 * st + 16 * (r >> 3) + (r & 7)) >= d0) v = 0.f; } sp[r] = v; }
                    const float sa = ((sp[0] + sp[1]) + (sp[2] + sp[3])) + ((sp[4] + sp[5]) + (sp[6] + sp[7])), sb = ((sp[8] + sp[9]) + (sp[10] + sp[11])) + ((sp[12] + sp[13]) + (sp[14] + sp[15]));
                    const float pa = xhalf(sa), pb = xhalf(sb);
                    float cB = R + (hi == 0 ? pb : 0.f), cA = R + sb + pb + (hi == 0 ? pa : 0.f);
#pragma unroll
                    for (int r = 15; r >= 8; --r) { cB += sp[r]; float a = EX2(s[st][r] - cB);
                        if (needmask) { if ((32 * st + 16 * (r >> 3) + (r & 7)) >= d0) a = 0.f; } s[st][r] = a; }
#pragma unroll
                    for (int r = 7; r >= 0; --r) { cA += sp[r]; float a = EX2(s[st][r] - cA);
                        if (needmask) { if ((32 * st + 16 * (r >> 3) + (r & 7)) >= d0) a = 0.f; } s[st][r] = a; }
                    R += (sa + sb) + (pa + pb);
                }
                wave_done = __all(R >= 160.f);
            } else {
                typedef float f32x2 __attribute__((ext_vector_type(2)));
                float mloc = -INFINITY;
                if (MODE == 0 && !(qsw_min - (64 * kt + 63) >= 128)) {
#pragma unroll
                    for (int st = 0; st < 2; ++st)
#pragma unroll
                        for (int r = 0; r < 16; ++r) { const int n = d0 - (32 * st + 16 * (r >> 3) + (r & 7)); const int nc = n < 0 ? 0 : (n > 128 ? 128 : n);
                            float v = s[st][r] * sc2 + (btab[nc] - m_run); if (n < 0) v = -INFINITY; s[st][r] = v; mloc = fmaxf(mloc, v); }
                } else {
                    const f32x2 scv = {sc2, sc2}, offv = {off_far, off_far};
#pragma unroll
                    for (int st = 0; st < 2; ++st)
#pragma unroll
                        for (int i = 0; i < 8; ++i) { f32x2 t = {s[st][2 * i], s[st][2 * i + 1]}; t = t * scv + offv; s[st][2 * i] = t.x; s[st][2 * i + 1] = t.y; mloc = fmaxf(mloc, fmaxf(t.x, t.y)); }
                }
                const bool first = (it == 0);
                float alpha = 1.f;
                if (first || __any(mloc > 8.f)) {
                    mloc = fmaxf(mloc, xhalf(mloc));
                    const float delta = first ? mloc : (mloc > 8.f ? mloc : 0.f);
                    alpha = first ? 1.f : EX2(-delta); m_run += delta; off_far -= delta;
                    const f32x2 dv = {delta, delta}, av = {alpha, alpha};
#pragma unroll
                    for (int dt = 0; dt < NDT; ++dt)
#pragma unroll
                        for (int i = 0; i < 8; ++i) { f32x2 t = {o[dt][2 * i], o[dt][2 * i + 1]}; t = t * av; o[dt][2 * i] = t.x; o[dt][2 * i + 1] = t.y; }
#pragma unroll
                    for (int st = 0; st < 2; ++st)
#pragma unroll
                        for (int i = 0; i < 8; ++i) { f32x2 t = {s[st][2 * i], s[st][2 * i + 1]}; t = t - dv; s[st][2 * i] = t.x; s[st][2 * i + 1] = t.y; }
                }
                f32x2 lsv = {0.f, 0.f};
                if (!PIPE) VLOADC(0, 0);
#pragma unroll
                for (int c4 = 0; c4 < 4; ++c4) { const int st = c4 >> 1, b8 = 8 * (c4 & 1);
                    float pe[8];
#pragma unroll
                    for (int i = 0; i < 8; ++i) pe[i] = EX2(s[st][b8 + i]);
#pragma unroll
                    for (int i = 0; i < 4; ++i) { const f32x2 t = {pe[2 * i], pe[2 * i + 1]}; lsv = lsv + t; }
                    u32x4 w; w.x = cvt_pk_bf16(pe[0], pe[1]); w.y = cvt_pk_bf16(pe[2], pe[3]); w.z = cvt_pk_bf16(pe[4], pe[5]); w.w = cvt_pk_bf16(pe[6], pe[7]);
                    const bf16x8 pkc = __builtin_bit_cast(bf16x8, w);
                    if (PIPE) { if (c4 + 1 < 4) VLOADC(c4 + 1, (c4 + 1) & (NFB - 1)); } else if (c4 > 0) VLOADC(c4, 0);
#pragma unroll
                    for (int dt = 0; dt < NDT; ++dt) o[dt] = MFMA32(vf[c4 & (NFB - 1)][dt], pkc, o[dt]);
                }
                const float ls = lsv.x + lsv.y;
                l_run = l_run * alpha + ls;
#if 0
                if (MODE == 0) {
                    __builtin_amdgcn_sched_group_barrier(0x002, 16, 0);
#pragma unroll
                    for (int c4 = 0; c4 < 3; ++c4)
#pragma unroll
                        for (int dt = 0; dt < NDT; ++dt) { __builtin_amdgcn_sched_group_barrier(0x008, 1, 0); __builtin_amdgcn_sched_group_barrier(0x100, 1, 0); __builtin_amdgcn_sched_group_barrier(0x002, 4, 0); }
                    __builtin_amdgcn_sched_group_barrier(0x008, NDT, 0);
                }
#endif
            }
            if (MODE == 1) {
            bf16x8 pk[4];
#pragma unroll
            for (int c4 = 0; c4 < 4; ++c4) { const int st = c4 >> 1, b8 = 8 * (c4 & 1); u32x4 w;
                w.x = cvt_pk_bf16(s[st][b8], s[st][b8 + 1]); w.y = cvt_pk_bf16(s[st][b8 + 2], s[st][b8 + 3]); w.z = cvt_pk_bf16(s[st][b8 + 4], s[st][b8 + 5]); w.w = cvt_pk_bf16(s[st][b8 + 6], s[st][b8 + 7]);
                pk[c4] = __builtin_bit_cast(bf16x8, w); }
#pragma unroll
            for (int dt = 0; dt < NDT; ++dt) {
                __builtin_amdgcn_sched_barrier(0);
                if (dt + 1 < NDT) VLOAD(dt + 1, (dt + 1) & 1);
#pragma unroll
                for (int c4 = 0; c4 < 4; ++c4) o[dt] = MFMA32(vf[dt & 1][c4], pk[c4], o[dt]);
            }
            }
            __builtin_amdgcn_sched_barrier(0);
#undef KLOAD
#undef VLOAD
#undef VLOADC
        }
        if (MODE == 1) { if (lane == 0) dflag[(it & 1) * 8 + (tid >> 6)] = wave_done ? 1u : 0u; }
#if PROBE_DUP == 23
        if (MODE == 0) __syncthreads();
#endif
        __syncthreads();
        if (MODE == 1) { const u32x4 f0 = *(const LAS u32x4*)(dflag + (it & 1) * 8), f1 = *(const LAS u32x4*)(dflag + (it & 1) * 8 + 4);
            if ((f0.x & f0.y & f0.z & f0.w & f1.x & f1.y & f1.z & f1.w) != 0u) all_done = true; }
      } }
    }
#undef GLOAD
#undef LSTORE
#undef TILE
}

__device__ __forceinline__ void zero_o(f32x16 (&o)[4]) {
#pragma unroll
    for (int dt = 0; dt < 4; ++dt)
#pragma unroll
        for (int r = 0; r < 16; ++r) o[dt][r] = 0.f;
}
__device__ __forceinline__ void diff_unit(const Params& p, LAS unsigned char* lds, int l, int b, int h, int qb, int wv) {
    const int tid_ = wv * 64 + pg8::lane_id();
    const int tid = tid_, lane = tid & 63, wid = tid >> 6, r32 = lane & 31, hi = lane >> 5;
    const bf16_t* P = (const bf16_t*)(p.ws + WS_P); const bf16_t* VT = (const bf16_t*)(p.ws + WS_VT); bf16_t* BR = (bf16_t*)(p.ws + WS_BR);
    const float* ctlf = (const float*)(p.ws + WS_CTL);
    LAS float* btab = (LAS float*)(lds + MISC_OFF + 256);
    if (tid < 129) btab[tid] = ctlf[CTL_BTAB + h * BT_STRIDE + tid];
    const float lam = ctlf[CTL_LAM + l];
    const int qsw_min = qb * 256 + wid * 32, tok = b * SEQ + qsw_min + r32, NT = 4 * (qb + 1);
    f32x16 o[4]; LAS unsigned* o0s = (LAS unsigned*)(lds + O0_OFF + wid * 8192) + lane;
    for (int c = 0; c < 2; ++c) {
        bf16x8 qf[4];
#pragma unroll
        for (int dc = 0; dc < 4; ++dc) qf[dc] = *(const bf16x8*)(P + (size_t)tok * LDP + C_DAQ + h * 128 + c * 64 + 16 * dc + 8 * hi);
        zero_o(o); float m_run = 0.f, l_run = 0.f;
        flash_pass<64, 0, 4, 3>(lds, P + (size_t)b * SEQ * LDP + C_DAK + h * 128 + c * 64, LDP, VT + (size_t)(h * 128) * NTOK + (size_t)b * SEQ, NTOK, qf, NT, qsw_min, 0.125f * LOG2E, btab, o, m_run, l_run, wv);
        const float lt = l_run + xhalf(l_run), inv = 1.f / lt;
        if (c == 0) {
#pragma unroll
            for (int dt = 0; dt < 4; ++dt)
#pragma unroll
                for (int r = 0; r < 8; ++r) o0s[(dt * 8 + r) * 64] = cvt_pk_bf16(o[dt][2 * r] * inv, o[dt][2 * r + 1] * inv);
        } else {
            const float li = lam * inv;
#pragma unroll
            for (int dt = 0; dt < 4; ++dt)
#pragma unroll
                for (int r = 0; r < 8; ++r) { const unsigned w0 = o0s[(dt * 8 + r) * 64]; o[dt][2 * r] = bflo(w0) - li * o[dt][2 * r]; o[dt][2 * r + 1] = bfhi(w0) - li * o[dt][2 * r + 1]; }
        }
    }
    const int lane_e = pg8::lane_id(), r32_e = lane_e & 31, hi_e = lane_e >> 5; const size_t tok_e = (size_t)(b * SEQ + qsw_min + r32_e);
    float ss = 0.f;
#pragma unroll
    for (int dt = 0; dt < 4; ++dt)
#pragma unroll
        for (int r = 0; r < 16; ++r) ss += o[dt][r] * o[dt][r];
    ss += xhalf(ss);
    const float rn = ctlf[CTL_LAM + 2 + l] / sqrtf(ss * (1.f / 128.f) + EPS);
    u32x2 zz[16]; f32x4 gg[16];
#pragma unroll
    for (int dt = 0; dt < 4; ++dt)
#pragma unroll
        for (int rg = 0; rg < 4; ++rg) { const int col = h * 128 + 32 * dt + 8 * rg + 4 * hi_e;
            zz[dt * 4 + rg] = *(const u32x2*)(P + tok_e * LDP + C_DAZ + col); gg[dt * 4 + rg] = *(const f32x4*)(p.da_norm_g + l * BW + col); }
#pragma unroll
    for (int dt = 0; dt < 4; ++dt)
#pragma unroll
        for (int rg = 0; rg < 4; ++rg) { const int col = h * 128 + 32 * dt + 8 * rg + 4 * hi_e;
            const u32x2 z = zz[dt * 4 + rg]; const f32x4 g = gg[dt * 4 + rg];
            u32x2 w; w.x = cvt_pk_bf16(o[dt][4 * rg] * rn * g[0] * silu_f(bflo(z.x)), o[dt][4 * rg + 1] * rn * g[1] * silu_f(bfhi(z.x)));
            w.y = cvt_pk_bf16(o[dt][4 * rg + 2] * rn * g[2] * silu_f(bflo(z.y)), o[dt][4 * rg + 3] * rn * g[3] * silu_f(bfhi(z.y)));
            *(u32x2*)(BR + tok_e * BW + col) = w; }
}
__device__ __forceinline__ void sb_unit(const Params& p, LAS unsigned char* lds, int b, int h, int qb, int wv) {
    const int tid_ = wv * 64 + pg8::lane_id();
    const int tid = tid_, lane = tid & 63, wid = tid >> 6, r32 = lane & 31, hi = lane >> 5;
    const bf16_t* P = (const bf16_t*)(p.ws + WS_P); const bf16_t* VT = (const bf16_t*)(p.ws + WS_VT); bf16_t* BR = (bf16_t*)(p.ws + WS_BR) + (size_t)1 * NTOK * BW;
    const int qsw_min = qb * 256 + wid * 32, tok = b * SEQ + qsw_min + r32, NT = 4 * (qb + 1);
    bf16x8 qf[8];
#pragma unroll
    for (int dc = 0; dc < 8; ++dc) qf[dc] = *(const bf16x8*)(P + (size_t)tok * LDP + C_SBQ + h * 128 + 16 * dc + 8 * hi);
    f32x16 o[4]; zero_o(o); float m_run = 0.f, l_run = 0.f;
    flash_pass<128, 1, 4, 1>(lds, P + (size_t)b * SEQ * LDP + C_SBK + h * 128, LDP, VT + (size_t)(1024 + h * 128) * NTOK + (size_t)b * SEQ, NTOK, qf, NT, qsw_min, 0.08838834764831845f * LOG2E, nullptr, o, m_run, l_run, wv);
    const int lane_e = pg8::lane_id(), r32_e = lane_e & 31, hi_e = lane_e >> 5; const size_t tok_e = (size_t)(b * SEQ + qsw_min + r32_e);
    u32x2 zz[16];
#pragma unroll
    for (int dt = 0; dt < 4; ++dt)
#pragma unroll
        for (int rg = 0; rg < 4; ++rg) zz[dt * 4 + rg] = *(const u32x2*)(P + tok_e * LDP + C_SBZ + h * 128 + 32 * dt + 8 * rg + 4 * hi_e);
#pragma unroll
    for (int dt = 0; dt < 4; ++dt)
#pragma unroll
        for (int rg = 0; rg < 4; ++rg) { const int col = h * 128 + 32 * dt + 8 * rg + 4 * hi_e;
            const u32x2 z = zz[dt * 4 + rg];
            u32x2 w; w.x = cvt_pk_bf16(o[dt][4 * rg] * silu_f(bflo(z.x)), o[dt][4 * rg + 1] * silu_f(bfhi(z.x)));
            w.y = cvt_pk_bf16(o[dt][4 * rg + 2] * silu_f(bflo(z.y)), o[dt][4 * rg + 3] * silu_f(bfhi(z.y)));
            *(u32x2*)(BR + tok_e * BW + col) = w; }
}
__device__ __forceinline__ void mem_unit(const Params& p, LAS unsigned char* lds, int l, int b, int hm, int qb, int quarter, int wv) {
    const int tid_ = wv * 64 + pg8::lane_id();
    const int tid = tid_, lane = tid & 63, wid = tid >> 6, r32 = lane & 31, hi = lane >> 5;
    const bf16_t* P = (const bf16_t*)(p.ws + WS_P); const bf16_t* MK = (const bf16_t*)(p.ws + WS_MKV + (size_t)(2 * l) * 2 * MiB); const bf16_t* MVT = (const bf16_t*)(p.ws + WS_MKV + (size_t)(2 * l + 1) * 2 * MiB); bf16_t* BR = (bf16_t*)(p.ws + WS_BR) + (size_t)3 * NTOK * BW;
    const int qsw_min = qb * 256 + wid * 32, tok = b * SEQ + qsw_min + r32;
    bf16x8 qf[16];
#pragma unroll
    for (int dc = 0; dc < 16; ++dc) qf[dc] = *(const bf16x8*)(P + (size_t)tok * LDP + C_MEMQ + hm * 256 + 16 * dc + 8 * hi);
    f32x16 o[2];
#pragma unroll
    for (int dt = 0; dt < 2; ++dt)
#pragma unroll
        for (int r = 0; r < 16; ++r) o[dt][r] = 0.f;
    float m_run = 0.f, l_run = 0.f;
    flash_pass<256, 2, 2, 1>(lds, MK + (size_t)(b * NMEM) * BW + hm * 256, BW, MVT + (size_t)(hm * 256 + quarter * 64) * NMEMTOK + b * NMEM, NMEMTOK, qf, 4, qsw_min, 0.0625f * LOG2E, nullptr, o, m_run, l_run, wv);
    const int lane_e = pg8::lane_id(), r32_e = lane_e & 31, hi_e = lane_e >> 5; const size_t tok_e = (size_t)(b * SEQ + qsw_min + r32_e);
    const float lt = l_run + xhalf(l_run), inv = 1.f / lt;
#pragma unroll
    for (int dt = 0; dt < 2; ++dt)
#pragma unroll
        for (int rg = 0; rg < 4; ++rg) { const int col = hm * 256 + quarter * 64 + 32 * dt + 8 * rg + 4 * hi_e;
            const u32x2 z = *(const u32x2*)(P + tok_e * LDP + C_MEMZ + col);
            u32x2 w; w.x = cvt_pk_bf16(o[dt][4 * rg] * inv * silu_f(bflo(z.x)), o[dt][4 * rg + 1] * inv * silu_f(bfhi(z.x)));
            w.y = cvt_pk_bf16(o[dt][4 * rg + 2] * inv * silu_f(bflo(z.y)), o[dt][4 * rg + 3] * inv * silu_f(bfhi(z.y)));
            *(u32x2*)(BR + tok_e * BW + col) = w; }
}
__device__ __forceinline__ void mem_unit2(const Params& p, LAS unsigned char* lds, int l, int b, int hm, int qb, int wv) {
    const bf16_t* P = (const bf16_t*)(p.ws + WS_P); const bf16_t* MK = (const bf16_t*)(p.ws + WS_MKV + (size_t)(2 * l) * 2 * MiB); const bf16_t* MVT = (const bf16_t*)(p.ws + WS_MKV + (size_t)(2 * l + 1) * 2 * MiB); bf16_t* BR = (bf16_t*)(p.ws + WS_BR) + (size_t)3 * NTOK * BW;
    const int lane = pg8::lane_id(), tid = wv * 64 + lane, r32 = lane & 31, hi = lane >> 5;
    const int qsw_min = qb * 256 + wv * 32; const size_t tok = (size_t)(b * SEQ + qsw_min + r32);
    const int pm = (r32 & 0x13) | ((r32 & 4) << 1) | ((r32 & 8) >> 1);
    constexpr int KP2 = 272, BUF2 = 18432;
    u32x4 sreg[2];
    f32x16 S[8];
#pragma unroll
    for (int i = 0; i < 8; ++i)
#pragma unroll
        for (int r = 0; r < 16; ++r) S[i][r] = 0.f;
#define GLK(IT) do { const int dh_ = (IT) >> 2, kt_ = (IT) & 3; _Pragma("unroll") for (int i_ = 0; i_ < 2; ++i_) { const int p_ = tid + 512 * i_, row_ = p_ >> 4, cp_ = p_ & 15; \
        sreg[i_] = *(const u32x4*)(MK + (size_t)(b * NMEM + 64 * kt_ + row_) * BW + hm * 256 + dh_ * 128 + cp_ * 8); } } while (0)
#define LSK(B) do { _Pragma("unroll") for (int i_ = 0; i_ < 2; ++i_) { const int p_ = tid + 512 * i_, row_ = p_ >> 4, cp_ = p_ & 15; *(LAS u32x4*)(lds + (B) * BUF2 + row_ * KP2 + cp_ * 16) = sreg[i_]; } } while (0)
    GLK(0); LSK(0); __syncthreads();
    bf16x8 qh[8];
#pragma unroll
    for (int it = 0; it < 8; ++it) {
        if (it + 1 < 8) GLK(it + 1);
        if ((it & 3) == 0) {
#pragma unroll
            for (int dc = 0; dc < 8; ++dc) qh[dc] = *(const bf16x8*)(P + tok * LDP + C_MEMQ + hm * 256 + (it >> 2) * 128 + 16 * dc + 8 * hi); }
        const LAS unsigned char* kb = lds + (it & 1) * BUF2;
        bf16x8 kf[2][4];
#pragma unroll
        for (int j = 0; j < 4; ++j) kf[0][j] = *(const LAS bf16x8*)(kb + (32 * (j & 1) + pm) * KP2 + (16 * (j >> 1) + 8 * hi) * 2);
#pragma unroll
        for (int g = 0; g < 4; ++g) {
            __builtin_amdgcn_sched_barrier(0);
            if (g + 1 < 4) {
#pragma unroll
                for (int j = 0; j < 4; ++j) kf[(g + 1) & 1][j] = *(const LAS bf16x8*)(kb + (32 * (j & 1) + pm) * KP2 + (16 * (2 * (g + 1) + (j >> 1)) + 8 * hi) * 2); }
#pragma unroll
            for (int j = 0; j < 4; ++j) S[2 * (it & 3) + (j & 1)] = MFMA32(kf[g & 1][j], qh[2 * g + (j >> 1)], S[2 * (it & 3) + (j & 1)]);
        }
        __builtin_amdgcn_sched_barrier(0);
        if (it + 1 < 8) LSK((it + 1) & 1);
        __syncthreads();
    }
#undef GLK
#undef LSK
    const float sc2 = 0.0625f * LOG2E;
    float mx = -INFINITY;
#pragma unroll
    for (int i = 0; i < 8; ++i)
#pragma unroll
        for (int r = 0; r < 16; ++r) mx = fmaxf(mx, S[i][r]);
    mx = fmaxf(mx, xhalf(mx));
    const float moff = -mx * sc2;
    float ls = 0.f; bf16x8 pk16[16];
#pragma unroll
    for (int c = 0; c < 16; ++c) { float pe[8];
#pragma unroll
        for (int i = 0; i < 8; ++i) { pe[i] = EX2(S[c >> 1][8 * (c & 1) + i] * sc2 + moff); ls += pe[i]; }
        u32x4 w; w.x = cvt_pk_bf16(pe[0], pe[1]); w.y = cvt_pk_bf16(pe[2], pe[3]); w.z = cvt_pk_bf16(pe[4], pe[5]); w.w = cvt_pk_bf16(pe[6], pe[7]); pk16[c] = __builtin_bit_cast(bf16x8, w); }
    const float inv = 1.f / (ls + xhalf(ls));
#define GLV(IT) do { const int dvh_ = (IT) >> 2, kt_ = (IT) & 3; _Pragma("unroll") for (int i_ = 0; i_ < 2; ++i_) { const int p_ = tid + 512 * i_, row_ = p_ >> 3, cp_ = p_ & 7; \
        sreg[i_] = *(const u32x4*)(MVT + (size_t)(hm * 256 + dvh_ * 128 + row_) * NMEMTOK + b * NMEM + 64 * kt_ + cp_ * 8); } } while (0)
#define LSV(B) do { _Pragma("unroll") for (int i_ = 0; i_ < 2; ++i_) { const int p_ = tid + 512 * i_, row_ = p_ >> 3, cp_ = p_ & 7; *(LAS u32x4*)(lds + (B) * BUF2 + row_ * VPITCH + cp_ * 16) = sreg[i_]; } } while (0)
    GLV(0); LSV(0); __syncthreads();
    f32x16 o[4];
#pragma unroll
    for (int it = 0; it < 8; ++it) {
        if (it + 1 < 8) GLV(it + 1);
        if ((it & 3) == 0) zero_o(o);
        const LAS unsigned char* vb = lds + (it & 1) * BUF2;
        bf16x8 vf[2][4];
#pragma unroll
        for (int j = 0; j < 4; ++j) vf[0][j] = *(const LAS bf16x8*)(vb + (32 * j + r32) * VPITCH + (8 * hi) * 2);
#pragma unroll
        for (int c4 = 0; c4 < 4; ++c4) {
            __builtin_amdgcn_sched_barrier(0);
            if (c4 + 1 < 4) {
#pragma unroll
                for (int j = 0; j < 4; ++j) vf[(c4 + 1) & 1][j] = *(const LAS bf16x8*)(vb + (32 * j + r32) * VPITCH + (16 * (c4 + 1) + 8 * hi) * 2); }
#pragma unroll
            for (int j = 0; j < 4; ++j) o[j] = MFMA32(vf[c4 & 1][j], pk16[4 * (it & 3) + c4], o[j]);
        }
        __builtin_amdgcn_sched_barrier(0);
        if (it + 1 < 8) LSV((it + 1) & 1);
        if ((it & 3) == 3) {
            u32x2 zz[16];
#pragma unroll
            for (int dt = 0; dt < 4; ++dt)
#pragma unroll
                for (int rg = 0; rg < 4; ++rg) zz[dt * 4 + rg] = *(const u32x2*)(P + tok * LDP + C_MEMZ + hm * 256 + (it >> 2) * 128 + 32 * dt + 8 * rg + 4 * hi);
#pragma unroll
            for (int dt = 0; dt < 4; ++dt)
#pragma unroll
                for (int rg = 0; rg < 4; ++rg) { const int col = hm * 256 + (it >> 2) * 128 + 32 * dt + 8 * rg + 4 * hi;
                    const u32x2 z = zz[dt * 4 + rg];
                    u32x2 w; w.x = cvt_pk_bf16(o[dt][4 * rg] * inv * silu_f(bflo(z.x)), o[dt][4 * rg + 1] * inv * silu_f(bfhi(z.x)));
                    w.y = cvt_pk_bf16(o[dt][4 * rg + 2] * inv * silu_f(bflo(z.y)), o[dt][4 * rg + 3] * inv * silu_f(bfhi(z.y)));
                    *(u32x2*)(BR + tok * BW + col) = w; } }
        __syncthreads();
    }
#undef GLV
#undef LSV
}
__device__ __forceinline__ void mixer_phase(const Params& p, LAS unsigned char* lds, int l, int ci, int kmask, int wv) {
    unsigned* ctr = (unsigned*)(p.ws + WS_CTL) + CTL_Q + 64 * ci;
    LAS unsigned* qw = (LAS unsigned*)(lds + MISC_OFF);
    for (;;) {
        if (wv == 0 && pg8::lane_id() == 0) *qw = atomicAdd(ctr, 1u);
        __syncthreads(); const unsigned u = *qw; __syncthreads();
        if (u >= 1280u) break;
        if (u < 1024u) { const int qb = 15 - (int)(u >> 6), r = (int)(u & 63), kind = r >> 5, bh = r & 31;
#ifndef NO_SB
            if (kind == 0 && (kmask & 1)) sb_unit(p, lds, bh >> 3, bh & 7, qb, wv);
#endif
#ifndef NO_DIFF
            if (kind == 1 && (kmask & 2)) diff_unit(p, lds, l, bh >> 3, bh & 7, qb, wv);
#endif
        } else { const int v = (int)u - 1024, qb = v & 15, bhm = v >> 4;
#ifndef NO_MEM
            if (kmask & 4) mem_unit2(p, lds, l, bhm >> 2, bhm & 3, qb, wv);
#endif
        }
    }
}
}

__global__ void __launch_bounds__(NTHR, 2) fwd_megakernel(Params p_arg) {
    extern __shared__ __attribute__((aligned(16))) unsigned char lds_raw[];
    LAS unsigned char* lds = (LAS unsigned char*)lds_raw;
    cg::grid_group grid = cg::this_grid();
    const int G = gridDim.x, bx = blockIdx.x, wave_s = __builtin_amdgcn_readfirstlane(threadIdx.x >> 6);
    (void)p_arg;
    if (threadIdx.x < 4) ((LAS unsigned*)(lds + MISC_OFF + 128))[threadIdx.x] = 0u;
    __syncthreads();
    (void)xcd_barrier_post((unsigned*)(kparams()->ws + WS_CTL) + CTL_BAR, (volatile LAS unsigned*)(lds + MISC_OFF + 128));
#define GRID_BAR() do { XcdBarrier xb_; xb_.bar = (unsigned*)(kparams()->ws + WS_CTL) + CTL_BAR; xb_.x = xb_xcc_id(); xb_.wv = wave_s; xb_.st = (volatile LAS unsigned*)(lds + MISC_OFF + 128); xcd_barrier(xb_); } while (0)
#define p (*kparams())
#define TIDS() const int wave = wave_s, lane = pg8::lane_id(), tid = wave * 64 + lane, gw = bx * NWAVES + wave, NGW = G * NWAVES; (void)lane; (void)gw; (void)NGW;
    if (bx == 0) { TIDS();
        float* ctlf = (float*)(p.ws + WS_CTL); unsigned* ctlu = (unsigned*)(p.ws + WS_CTL);
        for (int i = tid; i < 8 * 129; i += NTHR) { const int h = i / 129, n = i % 129; int bucket;
            if (n < 16) bucket = n; else { const float t = logf((float)n / 16.f) / logf(8.f) * 16.f; int lg = 16 + (int)t; bucket = lg > 31 ? 31 : lg; }
            if (n >= 128) bucket = 31;
            ctlf[CTL_BTAB + h * BT_STRIDE + n] = p.rel_bias[bucket * 8 + h] * LOG2E; }
        if (tid >= 64 && tid < 66) { const int l = tid - 64; float s1 = 0.f, s2 = 0.f;
            for (int i = 0; i < 64; ++i) { s1 += p.lq1[l * 64 + i] * p.lk1[l * 64 + i]; s2 += p.lq2[l * 64 + i] * p.lk2[l * 64 + i]; }
            const float lam_init = 0.8f - 0.6f * expf(-0.3f * (float)l); ctlf[CTL_LAM + l] = expf(s1) - expf(s2) + lam_init; ctlf[CTL_LAM + 2 + l] = 1.f - lam_init; }
    }
    { TIDS(); convert_weights(p, lds, gw, NGW, wave, lane);
#if PROBE_DUP == 3
      convert_weights(p, lds, gw, NGW, wave, lane);
#endif
      norm_phase(p, 0, p.x, gw, NGW, lane); }
    grid.sync();
    for (int l = 0; l < DEPTH; ++l) {
        const bf16_t* WT = (const bf16_t*)(p.ws + WS_WT + (size_t)l * WT_LAYER);
        bf16_t* H = (bf16_t*)(p.ws + WS_H); bf16_t* PB = (bf16_t*)(p.ws + WS_P);
#if PROBE_DUP == 2
        for (int rep_ = 0; rep_ < 2; ++rep_)
#endif
        { pg8::Gemm g{(const bf16_t*)p.ws, (const bf16_t*)p.ws, wave_s, 0, DM}; pg8::SchedP1 S{(int)(WS_H / MiB), (int)((WS_WT + (size_t)l * WT_LAYER) / MiB), G, bx};
          pg8::EpiP1 E{p.ws, p.gate_b + (size_t)l * 4 * DM, wave_s};
          pg8::gemm_phase<pg8::EpiP1, pg8::SchedP1, true, true>(lds, g, S, E); }
        GRID_BAR();
        { const bool memg = (l == 0) && (bx < 64) && (G > 64);
          if (memg) { pg8::Gemm g{(const bf16_t*)p.ws, (const bf16_t*)p.ws, wave_s, 0, DM}; pg8::SchedMem S{(int)(WS_MEMN / MiB), (int)(WS_WT / MiB), (int)(WT_LAYER / MiB), G, bx};
              pg8::EpiP1 E{p.ws, p.gate_b, wave_s};
              pg8::gemm_phase<pg8::EpiP1, pg8::SchedMem, true, true>(lds, g, S, E); }
          else { TIDS(); const int sk = (l == 0 && G > 64) ? 64 : 0; pooled_phase(p, (bx - sk) * NTHR + tid, (G - sk) * NTHR); } }
        GRID_BAR();
#ifndef NO_ATT
        att::mixer_phase(p, lds, l, l, 7, wave_s);
#if PROBE_DUP >= 11 && PROBE_DUP <= 17
        att::mixer_phase(p, lds, l, l + 2, PROBE_DUP - 10, wave_s);
#endif
#endif
#ifndef NO_G3
        { pg8::Gemm g{(const bf16_t*)(p.ws + WS_POOLED), (const bf16_t*)(p.ws + WS_WT + (size_t)l * WT_LAYER + WT_POOL), wave_s, 0, 256}; pg8::SchedPool S{G, bx};
          pg8::EpiPool E{PB, p.pool_scale + l * BW, (bf16_t*)(p.ws + WS_BR) + (size_t)2 * NTOK * BW, wave_s};
          pg8::gemm_phase<pg8::EpiPool, pg8::SchedPool, true, true>(lds, g, S, E); }
#endif

        GRID_BAR();
#if PROBE_DUP == 4
        for (int rep_ = 0; rep_ < 2; ++rep_)
#endif
#ifndef NO_G4
        { pg8::Gemm g{(const bf16_t*)(p.ws + WS_BR), (const bf16_t*)(p.ws + WS_WT + (size_t)l * WT_LAYER + WT_BR), wave_s, 0, BW}; pg8::SchedBranch S{G, bx};
          pg8::EpiMergeChain E{PB, H, wave_s};
          pg8::gemm_phase<pg8::EpiMergeChain, pg8::SchedBranch, true, true>(lds, g, S, E); }
#endif
        GRID_BAR();
#ifndef NO_G5
        { pg8::Gemm g{H, (const bf16_t*)(p.ws + WS_WT + (size_t)l * WT_LAYER + WT_OUT), wave_s, 0, DM}; pg8::Sched2 S{64, 8, G, bx};
          pg8::EpiOut E{l == 0 ? p.x : p.out, p.out, wave_s};
          pg8::gemm_phase<pg8::EpiOut, pg8::Sched2, true, true>(lds, g, S, E); }
#endif

        GRID_BAR();
        if (l + 1 < DEPTH) { { TIDS(); norm_phase(p, l + 1, p.out, gw, NGW, lane); } GRID_BAR(); }
    }
#if PROBE_DUP == 5
    for (int rep_ = 0; rep_ < 20; ++rep_) GRID_BAR();
#endif
    { TIDS(); final_norm_phase(p, gw, NGW, lane); }
#undef p
}

extern "C" void kernel_launch(void* const* d_in, const int* in_sizes, int n_in, void* d_out, int out_size, void* d_ws, size_t ws_size, hipStream_t stream) {
    static int grid = 0;
    if (grid == 0) {
        if (n_in != 18 || out_size != NTOK * DM || ws_size < WS_END) { fprintf(stderr, "kernel_launch: unexpected shapes (n_in %d out %d ws %zu)\n", n_in, out_size, ws_size); grid = -1; return; }
        int dev = 0, cus = 0, per_cu = 0;
        hipGetDevice(&dev); hipDeviceGetAttribute(&cus, hipDeviceAttributeMultiprocessorCount, dev);
        if (hipFuncSetAttribute((const void*)fwd_megakernel, hipFuncAttributeMaxDynamicSharedMemorySize, LDS_BYTES) != hipSuccess) fprintf(stderr, "kernel_launch: hipFuncSetAttribute failed\n");
        if (hipOccupancyMaxActiveBlocksPerMultiprocessor(&per_cu, (const void*)fwd_megakernel, NTHR, LDS_BYTES) != hipSuccess || per_cu < 1) { fprintf(stderr, "kernel_launch: occupancy query gave %d\n", per_cu); per_cu = 1; }
        (void)hipGetLastError();
        grid = cus * per_cu;
    }
    if (grid < 0) return;
    Params p{};
    p.x = (const float*)d_in[0]; p.mem = (const float*)d_in[1]; p.rel_bias = (const float*)d_in[2]; p.norm_g = (const float*)d_in[3]; p.w_in = (const float*)d_in[4]; p.gate_b = (const float*)d_in[5];
    p.lq1 = (const float*)d_in[6]; p.lk1 = (const float*)d_in[7]; p.lq2 = (const float*)d_in[8]; p.lk2 = (const float*)d_in[9]; p.da_norm_g = (const float*)d_in[10]; p.w_pool = (const float*)d_in[11];
    p.pool_scale = (const float*)d_in[12]; p.mem_norm_g = (const float*)d_in[13]; p.w_mem_kv = (const float*)d_in[14]; p.w_branch = (const float*)d_in[15]; p.w_out = (const float*)d_in[16]; p.final_g = (const float*)d_in[17];
    p.out = (float*)d_out; p.ws = (unsigned char*)d_ws;
    if (hipMemsetAsync(d_ws, 0, CTL_ZERO_BYTES, stream) != hipSuccess) { fprintf(stderr, "kernel_launch: memset failed\n"); return; }
    void* args[] = {&p};
    hipError_t e = hipLaunchCooperativeKernel((const void*)fwd_megakernel, dim3(grid), dim3(NTHR), args, LDS_BYTES, stream);
    if (e != hipSuccess) fprintf(stderr, "kernel_launch: cooperative launch failed: %s (grid %d)\n", hipGetErrorString(e), grid);
}
```
